# Optimizing an MI355X kernel written in HIP

```python
import math
import jax, jax.numpy as jnp
from jax import lax
import numpy as np

D_MODEL = 1024
BATCH = 2
SEQ = 8192
DEPTH = 2

CHUNK = 64
Q_BLOCK = 128
MEM_LEN = 256
GMLP_BLOCK = 128
A_GROUPS = 4
A_CH = 128
A_WIDTH = A_GROUPS * A_CH
B_HEADS = 4
B_HEAD_DIM = 128
B_WIDTH = B_HEADS * B_HEAD_DIM
C_HEADS = 4
C_QK_DIM = 64
C_V_DIM = 2 * C_QK_DIM
C_WIDTH = C_HEADS * C_V_DIM
D_GROUPS = 8
D_WIDTH = 512
CONV_W = 3
EVEN_IN = 2 * A_WIDTH + 3 * B_WIDTH + B_HEADS
ODD_IN = 2 * (2 * C_HEADS * C_QK_DIM) + C_WIDTH + 3 * D_WIDTH
EVEN_MIX = A_WIDTH + B_WIDTH
ODD_MIX = C_WIDTH + D_WIDTH
M_HEADS = 4
M_HEAD_DIM = D_MODEL // M_HEADS
D_FF = 2816
N_EXPERTS = 8
TOP_K = 2
D_FF_EXPERT = 3584
REL_BUCKETS = 32
REL_MAX_DIST = 128
EPS = 1e-6
N_EVEN = (DEPTH + 1) // 2
N_ODD = DEPTH // 2

kernel_name = 'hybrid_streaming_encoder_gmlp_fox_diffattn_shortconv_moe'


def rmsnorm(x, g):
    xf = x.astype(jnp.float32)
    y = xf * lax.rsqrt(jnp.mean(xf * xf, axis=-1, keepdims=True) + EPS)
    return (y * g.astype(jnp.float32)).astype(x.dtype)


def split_cols(z, widths):
    offs = np.cumsum([0] + list(widths))
    return [z[..., int(a):int(b)] for a, b in zip(offs[:-1], offs[1:])]


def to_blocks(t):
    b, h, s, d = t.shape
    return t.reshape(b, h, s // Q_BLOCK, Q_BLOCK, d).transpose(2, 0, 1, 3, 4)


def from_blocks(t):
    nb, b, h, q, d = t.shape
    return t.transpose(1, 2, 0, 3, 4).reshape(b, h, nb * q, d)


def swiglu(h, wg, wu, wd):
    return (jax.nn.silu(h @ wg) * (h @ wu)) @ wd


def gmlp_spatial_gate(u, v, v_gain, w_s, b_s):
    bsz, s, _ = u.shape
    nblk = s // GMLP_BLOCK
    u = jax.nn.gelu(u).reshape(bsz, nblk, GMLP_BLOCK, A_GROUPS, A_CH)
    v = jax.nn.gelu(v).reshape(bsz, nblk, GMLP_BLOCK, A_GROUPS, A_CH)
    v = rmsnorm(v, v_gain.reshape(A_GROUPS, A_CH))
    pos = jnp.arange(GMLP_BLOCK)
    mask = (pos[None, :] // CHUNK) <= (pos[:, None] // CHUNK)
    w = jnp.where(mask[None], w_s, 0)
    mixed = jnp.einsum('gij,bnjgc->bnigc', w, v) + b_s.T[None, None, :, :, None]
    return (u * mixed).reshape(bsz, s, A_WIDTH)


def forgetting_attention(q, k, v, f_logit):
    b, h, s, _ = q.shape
    nb = s // Q_BLOCK
    c = jnp.cumsum(jax.nn.log_sigmoid(f_logit.astype(jnp.float32)), axis=-1)
    cb = c.reshape(b, h, nb, Q_BLOCK).transpose(2, 0, 1, 3)
    kpos = jnp.arange(s)
    scale = B_HEAD_DIM ** -0.5

    def block(args):
        qi, ci, bi = args
        qpos = bi * Q_BLOCK + jnp.arange(Q_BLOCK)
        lg = jnp.einsum('bhqd,bhkd->bhqk', qi, k).astype(jnp.float32) * scale
        lg = lg + ci[..., :, None] - c[:, :, None, :]
        lg = jnp.where(kpos[None, :] <= qpos[:, None], lg, -jnp.inf)
        p = jax.nn.softmax(lg, axis=-1).astype(v.dtype)
        return jnp.einsum('bhqk,bhkd->bhqd', p, v)

    return from_blocks(lax.map(block, (to_blocks(q), cb, jnp.arange(nb))))


def rel_bucket(rel):
    n_half = REL_BUCKETS // 2
    max_exact = n_half // 2
    ret = jnp.where(rel > 0, n_half, 0)
    n = jnp.abs(rel)
    nf = jnp.maximum(n, 1).astype(jnp.float32)
    large = max_exact + (jnp.log(nf / max_exact) / math.log(REL_MAX_DIST / max_exact)
                         * (n_half - max_exact)).astype(jnp.int32)
    large = jnp.minimum(large, n_half - 1)
    return ret + jnp.where(n < max_exact, n, large)


def differential_attention(q1, q2, k1, k2, v, lam, rel_table):
    s = q1.shape[2]
    nb = s // Q_BLOCK
    kpos = jnp.arange(s)
    scale = C_QK_DIM ** -0.5

    def block(args):
        q1i, q2i, bi = args
        qpos = bi * Q_BLOCK + jnp.arange(Q_BLOCK)
        bias = rel_table[rel_bucket(kpos[None, :] - qpos[:, None])]
        bias = bias.transpose(2, 0, 1).astype(jnp.float32)[None]
        mask = (kpos[None, :] // CHUNK) <= (qpos[:, None] // CHUNK)

        def probs(qi, ki):
            lg = jnp.einsum('bhqd,bhkd->bhqk', qi, ki).astype(jnp.float32) * scale + bias
            return jax.nn.softmax(jnp.where(mask, lg, -jnp.inf), axis=-1)

        p = probs(q1i, k1) - lam * probs(q2i, k2)
        return jnp.einsum('bhqk,bhkd->bhqd', p.astype(v.dtype), v)

    return from_blocks(lax.map(block, (to_blocks(q1), to_blocks(q2), jnp.arange(nb))))


def short_conv_mixer(h, gb, gc, conv_w):
    y = gc * h
    y = lax.conv_general_dilated(y, conv_w[:, None, :].astype(y.dtype), window_strides=(1,),
                                 padding=[(CONV_W - 1, 0)], dimension_numbers=('NWC', 'WIO', 'NWC'),
                                 feature_group_count=D_WIDTH)
    return gb * y


def even_mixer(xn, w_in, b_f, v_gain, w_s, b_s, w_out):
    b, s, _ = xn.shape
    u, v, q, k, vv, f = split_cols(xn @ w_in, [A_WIDTH, A_WIDTH, B_WIDTH, B_WIDTH, B_WIDTH, B_HEADS])
    ya = gmlp_spatial_gate(u, v, v_gain, w_s, b_s)
    heads = lambda t: t.reshape(b, s, B_HEADS, B_HEAD_DIM).transpose(0, 2, 1, 3)
    yb = forgetting_attention(heads(q), heads(k), heads(vv), (f + b_f).transpose(0, 2, 1))
    yb = yb.transpose(0, 2, 1, 3).reshape(b, s, B_WIDTH)
    return jnp.concatenate([ya, yb], axis=-1) @ w_out


def odd_mixer(xn, w_in, lq1, lk1, lq2, lk2, subln_gain, conv_w, rel_table, w_out, lam_init):
    b, s, _ = xn.shape
    qk_w = 2 * C_HEADS * C_QK_DIM
    q, k, v, h, gb, gc = split_cols(xn @ w_in, [qk_w, qk_w, C_WIDTH, D_WIDTH, D_WIDTH, D_WIDTH])
    q = q.reshape(b, s, 2, C_HEADS, C_QK_DIM).transpose(2, 0, 3, 1, 4)
    k = k.reshape(b, s, 2, C_HEADS, C_QK_DIM).transpose(2, 0, 3, 1, 4)
    v = v.reshape(b, s, C_HEADS, C_V_DIM).transpose(0, 2, 1, 3)
    lam = (jnp.exp(jnp.sum(lq1.astype(jnp.float32) * lk1.astype(jnp.float32)))
           - jnp.exp(jnp.sum(lq2.astype(jnp.float32) * lk2.astype(jnp.float32))) + lam_init)
    o = differential_attention(q[0], q[1], k[0], k[1], v, lam, rel_table)
    o = rmsnorm(o, subln_gain.reshape(C_HEADS, 1, C_V_DIM)) * (1.0 - lam_init)
    yc = o.transpose(0, 2, 1, 3).reshape(b, s, C_WIDTH)
    yd = short_conv_mixer(h, gb, gc, conv_w)
    return jnp.concatenate([yc, yd], axis=-1) @ w_out


def memory_cross_attention(xn, memn, w_q, w_kv, w_o):
    b, s, _ = xn.shape
    m = memn.shape[1]
    q = (xn @ w_q).reshape(b, s, M_HEADS, M_HEAD_DIM)
    kv = (memn @ w_kv).reshape(b, m, 2, M_HEADS, M_HEAD_DIM)
    k, v = kv[:, :, 0], kv[:, :, 1]
    lg = jnp.einsum('bshd,bmhd->bhsm', q, k).astype(jnp.float32) * M_HEAD_DIM ** -0.5
    p = jax.nn.softmax(lg, axis=-1).astype(v.dtype)
    o = jnp.einsum('bhsm,bmhd->bshd', p, v).reshape(b, s, D_MODEL)
    return o @ w_o


def moe_swiglu(h, w_router, wg, wu, wd):
    b, s, d = h.shape
    t = h.reshape(b * s, d)
    logits = (t @ w_router).astype(jnp.float32)
    top_v, top_i = lax.top_k(logits, TOP_K)
    gates = jax.nn.softmax(top_v, axis=-1)
    combine = jnp.sum(jax.nn.one_hot(top_i, N_EXPERTS, dtype=jnp.float32) * gates[..., None], axis=1)
    out = jnp.zeros_like(t)
    for e in range(N_EXPERTS):
        out = out + combine[:, e:e + 1].astype(t.dtype) * swiglu(t, wg[e], wu[e], wd[e])
    return out.reshape(b, s, d)


def setup_inputs(seed: int = 0) -> dict:
    key = jax.random.key(seed)
    ks = iter(jax.random.split(key, 48))
    f32 = jnp.float32

    def nrm(shape, fan_in):
        return jax.random.normal(next(ks), shape, f32) * fan_in ** -0.5

    def gain(shape):
        return 1.0 + 0.05 * jax.random.normal(next(ks), shape, f32)

    return {
        'x': jax.random.normal(next(ks), (BATCH, SEQ, D_MODEL), f32),
        'mem': jax.random.normal(next(ks), (BATCH, MEM_LEN, D_MODEL), f32),
        'norm_mix': gain((DEPTH, D_MODEL)),
        'norm_mem_q': gain((DEPTH, D_MODEL)),
        'norm_mem_kv': gain((DEPTH, D_MODEL)),
        'norm_ffn': gain((DEPTH, D_MODEL)),
        'norm_final': gain((D_MODEL,)),
        'even_w_in': nrm((N_EVEN, D_MODEL, EVEN_IN), D_MODEL),
        'fox_b_f': jax.random.uniform(next(ks), (N_EVEN, B_HEADS), f32, 1.0, 4.0),
        'gmlp_v_gain': gain((N_EVEN, A_WIDTH)),
        'gmlp_w_s': nrm((N_EVEN, A_GROUPS, GMLP_BLOCK, GMLP_BLOCK), GMLP_BLOCK),
        'gmlp_b_s': 1.0 + 0.1 * jax.random.normal(next(ks), (N_EVEN, A_GROUPS, GMLP_BLOCK), f32),
        'even_w_out': nrm((N_EVEN, EVEN_MIX, D_MODEL), EVEN_MIX),
        'odd_w_in': nrm((N_ODD, D_MODEL, ODD_IN), D_MODEL),
        'diff_lambda_q1': 0.1 * jax.random.normal(next(ks), (N_ODD, C_QK_DIM), f32),
        'diff_lambda_k1': 0.1 * jax.random.normal(next(ks), (N_ODD, C_QK_DIM), f32),
        'diff_lambda_q2': 0.1 * jax.random.normal(next(ks), (N_ODD, C_QK_DIM), f32),
        'diff_lambda_k2': 0.1 * jax.random.normal(next(ks), (N_ODD, C_QK_DIM), f32),
        'diff_subln_gain': gain((N_ODD, C_WIDTH)),
        'conv_w': nrm((N_ODD, CONV_W, D_WIDTH), CONV_W),
        'odd_w_out': nrm((N_ODD, ODD_MIX, D_MODEL), ODD_MIX),
        'rel_bias': 0.2 * jax.random.normal(next(ks), (REL_BUCKETS, C_HEADS), f32),
        'mem_w_q': nrm((DEPTH, D_MODEL, D_MODEL), D_MODEL),
        'mem_w_kv': nrm((DEPTH, D_MODEL, 2 * D_MODEL), D_MODEL),
        'mem_w_o': nrm((DEPTH, D_MODEL, D_MODEL), D_MODEL),
        'ffn_w_gate': nrm((N_EVEN, D_MODEL, D_FF), D_MODEL),
        'ffn_w_up': nrm((N_EVEN, D_MODEL, D_FF), D_MODEL),
        'ffn_w_down': nrm((N_EVEN, D_FF, D_MODEL), D_FF),
        'router_w': nrm((N_ODD, D_MODEL, N_EXPERTS), D_MODEL),
        'moe_w_gate': nrm((N_ODD, N_EXPERTS, D_MODEL, D_FF_EXPERT), D_MODEL),
        'moe_w_up': nrm((N_ODD, N_EXPERTS, D_MODEL, D_FF_EXPERT), D_MODEL),
        'moe_w_down': nrm((N_ODD, N_EXPERTS, D_FF_EXPERT, D_MODEL), D_FF_EXPERT),
    }


def reference(x, mem, norm_mix, norm_mem_q, norm_mem_kv, norm_ffn, norm_final,
              even_w_in, fox_b_f, gmlp_v_gain, gmlp_w_s, gmlp_b_s, even_w_out,
              odd_w_in, diff_lambda_q1, diff_lambda_k1, diff_lambda_q2, diff_lambda_k2,
              diff_subln_gain, conv_w, odd_w_out, rel_bias,
              mem_w_q, mem_w_kv, mem_w_o,
              ffn_w_gate, ffn_w_up, ffn_w_down,
              router_w, moe_w_gate, moe_w_up, moe_w_down):
    for l in range(DEPTH):
        i = l // 2
        xn = rmsnorm(x, norm_mix[l])
        if l % 2 == 0:
            x = x + even_mixer(xn, even_w_in[i], fox_b_f[i], gmlp_v_gain[i], gmlp_w_s[i],
                               gmlp_b_s[i], even_w_out[i])
        else:
            lam_init = 0.8 - 0.6 * math.exp(-0.3 * l)
            x = x + odd_mixer(xn, odd_w_in[i], diff_lambda_q1[i], diff_lambda_k1[i],
                              diff_lambda_q2[i], diff_lambda_k2[i], diff_subln_gain[i],
                              conv_w[i], rel_bias, odd_w_out[i], lam_init)
        x = x + memory_cross_attention(rmsnorm(x, norm_mem_q[l]), rmsnorm(mem, norm_mem_kv[l]),
                                       mem_w_q[l], mem_w_kv[l], mem_w_o[l])
        h = rmsnorm(x, norm_ffn[l])
        if l % 2 == 0:
            x = x + swiglu(h, ffn_w_gate[i], ffn_w_up[i], ffn_w_down[i])
        else:
            x = x + moe_swiglu(h, router_w[i], moe_w_gate[i], moe_w_up[i], moe_w_down[i])
    return rmsnorm(x, norm_final)
```

```cpp
#include <hip/hip_runtime.h>
#include <cstdio>
#include <cstdint>

#ifndef MK_PER_PHASE
#define MK_PER_PHASE 0
#endif

#ifndef MOE_FP8
#define MOE_FP8 1
#endif
#define LAS __attribute__((address_space(3)))
#define GAS __attribute__((address_space(1)))
typedef unsigned short bf16_t;
typedef short bf16x8 __attribute__((ext_vector_type(8)));
typedef float f32x4 __attribute__((ext_vector_type(4)));
typedef float f32x2 __attribute__((ext_vector_type(2)));
typedef unsigned u32x4 __attribute__((ext_vector_type(4)));
typedef unsigned u32x2 __attribute__((ext_vector_type(2)));
typedef GAS unsigned gu32;
typedef int v8i_t __attribute__((ext_vector_type(8)));

constexpr int D = 1024, BATCH = 2, SEQ = 8192, M = BATCH * SEQ, MEMLEN = 256;
constexpr int EVEN_IN = 2564, EVEN_N = 2560, ODD_IN = 3072, FF = 2816, NE = 8, FFE = 3584;
constexpr float EPS = 1e-6f;
constexpr float LOG2E = 1.4426950408889634f;
constexpr int MOE_ROWS = 34816;
constexpr int MOE_TILES = MOE_ROWS / 256;

constexpr size_t MiB = 1u << 20;
constexpr size_t WS_CTL = 0, CTL_ZERO_BYTES = 64 * 1024;
constexpr size_t WS_CNT = 1 * MiB;
constexpr size_t WS_TOKE = WS_CNT + 8192;
constexpr size_t WS_GATE = WS_TOKE + (size_t)M * 4;
constexpr size_t WS_SLOT = WS_GATE + (size_t)M * 8;
constexpr size_t WS_RS5 = WS_SLOT + (size_t)M * 8;
constexpr size_t WS_RSS = WS_RS5 + (size_t)M * 4;
constexpr size_t WS_FL = WS_RSS + (size_t)MOE_ROWS * 4;
constexpr size_t WS_CUM = WS_FL + (size_t)M * 16;
constexpr size_t WS_WRT = WS_CUM + (size_t)8 * SEQ * 4;
constexpr size_t WS_SMALL_END = WS_WRT + (size_t)8 * D * 4;
static_assert(WS_SMALL_END <= 4 * MiB, "small region");
constexpr size_t WS_SSP = 4 * MiB;
constexpr size_t SSP_BYTES = (size_t)M * 16 * 4;
constexpr size_t WS_WGUE = 16 * MiB;
constexpr size_t WS_WDE = 128 * MiB;
constexpr size_t WS_YMOE = 16 * MiB;
constexpr size_t WS_WIN0 = 184 * MiB;
constexpr size_t WS_WOUT0 = 189 * MiB;
constexpr size_t WS_WIN1 = 191 * MiB;
constexpr size_t WS_WOUT1 = 197 * MiB;
constexpr size_t WS_WKV = 199 * MiB;
constexpr size_t WS_WQG = 207 * MiB;
constexpr size_t WS_WOT = 211 * MiB;
constexpr size_t WS_WGU0 = 215 * MiB;
constexpr size_t WS_WD0 = 226 * MiB;
constexpr size_t WS_MEMN = 232 * MiB;
constexpr size_t WS_KV = 234 * MiB;
constexpr size_t WS_AT = 238 * MiB;
constexpr size_t WS_BT = 246 * MiB;
constexpr size_t WS_XB = 256 * MiB;
constexpr size_t WS_Y = 288 * MiB;
constexpr size_t WS_Z = 320 * MiB;
constexpr size_t WS_AMOE = 184 * MiB;
constexpr size_t WS_HMOE = 288 * MiB;
static_assert(MOE_FP8, "the workspace map places the expert hidden activations for the fp8 path");
constexpr size_t WS_PART = 408 * MiB;
constexpr size_t WS_END = 490 * MiB;
static_assert(WS_WD0 + (size_t)D * FF * 2 <= WS_MEMN && WS_BT + 8 * MiB <= WS_XB && WS_Z + (size_t)M * 3072 * 2 <= WS_END, "map");
static_assert(WS_AMOE + (size_t)MOE_ROWS * D * 2 <= WS_HMOE && WS_YMOE + (size_t)MOE_ROWS * D * 2 <= WS_WDE, "map2");

constexpr int CW_BAR = 4096;
constexpr int CW_NRM = 8192;
constexpr int CW_MOEQ = 8256;
constexpr int CW_NRM2 = 9000;
constexpr int CW_QCTR = 8320;

constexpr int RING_BYTES = 131072;
constexpr int EPI_OFF = RING_BYTES;
constexpr int JOB_OFF = 140 * 1024;
constexpr int LDS_BYTES = 152 * 1024;
constexpr int MISC_OFF = LDS_BYTES - 256;

#define RLX_AGENT __ATOMIC_RELAXED, __HIP_MEMORY_SCOPE_AGENT
#define LDS_WAIT() asm volatile("s_waitcnt lgkmcnt(0)" ::: "memory")
#define VM_WAIT() asm volatile("s_waitcnt vmcnt(0)" ::: "memory")
__device__ __forceinline__ unsigned cvt_pk_bf16(float lo, float hi) { unsigned r; asm("v_cvt_pk_bf16_f32 %0, %1, %2" : "=v"(r) : "v"(lo), "v"(hi)); return r; }
__device__ __forceinline__ unsigned pk4_fp8(float a, float b, float c, float d) {
    int w = __builtin_amdgcn_cvt_pk_fp8_f32(a, b, 0, false); w = __builtin_amdgcn_cvt_pk_fp8_f32(c, d, w, true); return (unsigned)w; }
__device__ __forceinline__ float bf2f(bf16_t b) { return __uint_as_float((unsigned)b << 16); }
__device__ __forceinline__ float bflo(unsigned w) { return __uint_as_float(w << 16); }
__device__ __forceinline__ float bfhi(unsigned w) { return __uint_as_float(w & 0xffff0000u); }
__device__ __forceinline__ float wave_sum(float v) {
#define WS_DPP(ctrl, rmask) v += __builtin_bit_cast(float, __builtin_amdgcn_update_dpp(0, __builtin_bit_cast(int, v), (ctrl), (rmask), 0xF, true))
    WS_DPP(0xB1, 0xF);
    WS_DPP(0x4E, 0xF);
    WS_DPP(0x141, 0xF);
    WS_DPP(0x140, 0xF);
    WS_DPP(0x142, 0xA);
    WS_DPP(0x143, 0xC);
#undef WS_DPP
    return __builtin_bit_cast(float, __builtin_amdgcn_readlane(__builtin_bit_cast(int, v), 63));
}
__device__ __forceinline__ float wave_max0(float v) {
#define WM_DPP(ctrl, rmask) v = fmaxf(v, __builtin_bit_cast(float, __builtin_amdgcn_update_dpp(0, __builtin_bit_cast(int, v), (ctrl), (rmask), 0xF, true)))
    WM_DPP(0xB1, 0xF); WM_DPP(0x4E, 0xF); WM_DPP(0x141, 0xF); WM_DPP(0x140, 0xF); WM_DPP(0x142, 0xA); WM_DPP(0x143, 0xC);
#undef WM_DPP
    return __builtin_bit_cast(float, __builtin_amdgcn_readlane(__builtin_bit_cast(int, v), 63));
}
__device__ __forceinline__ float fast_exp2(float x) { return __builtin_amdgcn_exp2f(x); }
__device__ __forceinline__ float fast_rcp(float x) { return __builtin_amdgcn_rcpf(x); }
__device__ __forceinline__ float gelu_tanh(float x) {
    constexpr float CA = -2.0f * LOG2E * 0.7978845608028654f, CB = CA * 0.044715f;
    return x * fast_rcp(1.0f + fast_exp2(x * fmaf(x * x, CB, CA)));
}
__device__ __forceinline__ float silu_f(float x) { return x * fast_rcp(1.0f + fast_exp2(-LOG2E * x)); }

#define XB_TMO      128
#define XB_XCNT(j)  (256  + 64 * (j))
#define XB_XSUB(j)  (1280 + 64 * (j))
#define XB_XGEN(j)  (2304 + 64 * (j))
#define XB_TOP      3328
#define XB_TOPGEN   3392
#define XCD_BAR_WORDS 3456
#define XB_SPIN_CAP (1u << 18)
__device__ __forceinline__ unsigned xb_ld(unsigned* p)              { return __hip_atomic_load(p, __ATOMIC_RELAXED, __HIP_MEMORY_SCOPE_AGENT); }
__device__ __forceinline__ unsigned xb_add(unsigned* p, unsigned v) { return __hip_atomic_fetch_add(p, v, __ATOMIC_RELAXED, __HIP_MEMORY_SCOPE_AGENT); }
__device__ __forceinline__ unsigned xb_xcc_id() { return (unsigned)__builtin_amdgcn_s_getreg((3 << 11) | 20) & 0xFu; }
#define XB_SPIN(cond, bar) do { unsigned _sp = 0; while (cond) { __builtin_amdgcn_s_sleep(1); \
    if ((++_sp & 255u) == 0u) { if (xb_ld(&(bar)[XB_TMO])) break; if (_sp > XB_SPIN_CAP) { atomicAdd(&(bar)[XB_TMO], 1u); break; } } } } while (0)
struct XcdBarrier { unsigned* bar; unsigned x; volatile LAS unsigned* st; };
__device__ __forceinline__ XcdBarrier xcd_barrier_post(unsigned* bar, volatile LAS unsigned* st) {
    XcdBarrier b; b.bar = bar; b.x = xb_xcc_id(); b.st = st;
    if (threadIdx.x == 0) (void)xb_add(&bar[XB_XCNT(b.x)], 1u);
    return b;
}
__device__ __forceinline__ void xcd_barrier_complete(unsigned* bar, unsigned x, unsigned& nloc, unsigned& nx) {
    const unsigned G = gridDim.x * gridDim.y * gridDim.z;
    unsigned sum, cnt, mine, sp = 0u;
    for (;;) {
        sum = 0u; cnt = 0u; mine = 0u;
#pragma unroll
        for (unsigned j = 0; j < 16; ++j) { const unsigned c = xb_ld(&bar[XB_XCNT(j)]); sum += c; cnt += (c > 0u) ? 1u : 0u; mine = (j == x) ? c : mine; }
        if (sum == G) break;
        __builtin_amdgcn_s_sleep(1);
        if ((++sp & 255u) == 0u) { if (xb_ld(&bar[XB_TMO])) break; if (sp > XB_SPIN_CAP) { atomicAdd(&bar[XB_TMO], 1u); break; } }
    }
    nloc = mine > 0u ? mine : 1u; nx = cnt > 0u ? cnt : 1u;
}
__device__ __forceinline__ void xcd_barrier(const XcdBarrier& b) {
    asm volatile("s_waitcnt vmcnt(0)" ::: "memory");
    __syncthreads();
    if (threadIdx.x == 0) {
        unsigned* bar = b.bar;
        __builtin_amdgcn_s_waitcnt(0);
        unsigned nloc = b.st[0], nx = b.st[1];
        if (nloc == 0u) { xcd_barrier_complete(bar, b.x, nloc, nx); b.st[0] = nloc; b.st[1] = nx; }
        const unsigned old = xb_add(&bar[XB_XSUB(b.x)], 1u);
        const unsigned gen = old / nloc;
        if (old + 1u == (gen + 1u) * nloc) {
            __builtin_amdgcn_fence(__ATOMIC_RELEASE, "agent");
            asm volatile("s_waitcnt vmcnt(0)" ::: "memory");
            const unsigned og = xb_add(&bar[XB_TOP], 1u);
            const unsigned tg = og / nx;
            if (og + 1u == (tg + 1u) * nx) xb_add(&bar[XB_TOPGEN], 1u);
            else XB_SPIN(xb_ld(&bar[XB_TOPGEN]) == tg, bar);
            __builtin_amdgcn_fence(__ATOMIC_ACQUIRE, "agent");
            xb_add(&bar[XB_XGEN(b.x)], 1u);
            asm volatile("s_waitcnt vmcnt(0)" ::: "memory");
        } else {
            XB_SPIN(xb_ld(&bar[XB_XGEN(b.x)]) == gen, bar);
            __builtin_amdgcn_fence(__ATOMIC_ACQUIRE, "agent");
            asm volatile("s_waitcnt vmcnt(0)" ::: "memory");
        }
    }
    __syncthreads();
}

namespace pg8 {
constexpr int BM = 256, BK = 64, HALF = 128, HTB = HALF * BK * 2, STAGE_BYTES = 8 * HTB, NXCD = 8, WGM = 4;
__host__ __device__ __forceinline__ int lds_byte(int r, int c) { const int st = (r >> 4) * 2 + (c >> 5), rr = r & 15, cc = c & 31, ob = rr * 64 + cc * 2; return st * 1024 + (ob ^ (((ob >> 9) & 1) << 5)); }
__host__ __device__ __forceinline__ void stage_rc(int b, int& R, int& C) { const int st = b / 1024, sb = b % 1024, swz = sb ^ (((sb >> 9) & 1) << 5); R = (st >> 1) * 16 + swz / 64; C = (st & 1) * 32 + (swz % 64) / 2; }
__host__ __device__ __forceinline__ int perm32(int rho) { const int n = rho >> 4, i = rho & 15; return 8 * (i >> 2) + 4 * n + (i & 3); }

struct Unit { const char* a; const char* b; int orow, ocol, tag, pad; };
struct Gemm { int lda, ldb, K; int ksA = 0; };

struct GridSched {
    int nM, nN, nwg, G, c;
    const char* A; const char* B; size_t aTile, bTile, bSel; int pmPerSel; int ocolStep;
    int tp1, tp2, tp3, tp4, tp5, tp6, tp7; bool byTable;
    __device__ __forceinline__ void init(int nM_, int nN_, int G_, int c_, const void* A_, size_t aTile_, const void* B_, size_t bTile_, int ocolStep_) {
        nM = nM_; nN = nN_; nwg = nM * nN; G = G_; c = c_; A = (const char*)A_; B = (const char*)B_; aTile = aTile_; bTile = bTile_; bSel = 0; pmPerSel = 1 << 30; ocolStep = ocolStep_; byTable = false;
        tp1 = tp2 = tp3 = tp4 = tp5 = tp6 = tp7 = 0; }
    __device__ __forceinline__ bool next(int i, Unit& u) const {
        const long L = (long)i * G + c; if (L >= nwg) return false;
        int wgid = (int)L; { const int q = nwg / NXCD, r = nwg % NXCD, xcd = wgid % NXCD, off = wgid / NXCD; wgid = (xcd < r ? xcd * (q + 1) : r * (q + 1) + (xcd - r) * q) + off; }
        const int nig = WGM * nN, gid = wgid / nig, fm = gid * WGM, gsz = (nM - fm) < WGM ? (nM - fm) : WGM;
        const int pm = fm + ((wgid % nig) % gsz), pn = (wgid % nig) / gsz;
        int sel = pm / pmPerSel;
        if (byTable) sel = (pm >= tp1) + (pm >= tp2) + (pm >= tp3) + (pm >= tp4) + (pm >= tp5) + (pm >= tp6) + (pm >= tp7);
        u.a = A + (size_t)pm * aTile; u.b = B + (size_t)pn * bTile + (size_t)sel * bSel; u.orow = pm * 256; u.ocol = pn * ocolStep; u.tag = pn; u.pad = 0; return true;
    }
};
template <class F> struct ListSched {
    int n, G, c; F f;
    __device__ __forceinline__ bool next(int i, Unit& u) const { const long L = (long)i * G + c; if (L >= n) return false; f((int)L, u); return true; }
};

__device__ __forceinline__ float row_scale(const float* ssp, int row) {
    const f32x4* p = (const f32x4*)(ssp + (size_t)row * 16); const f32x4 a = p[0], b = p[1], c = p[2], d = p[3];
    const float s = ((a[0] + a[1]) + (a[2] + a[3])) + ((b[0] + b[1]) + (b[2] + b[3])) + ((c[0] + c[1]) + (c[2] + c[3])) + ((d[0] + d[1]) + (d[2] + d[3]));
    return 1.0f / sqrtf(s * (1.0f / 1024.0f) + EPS);
}
constexpr int RSL_OFF = EPI_OFF + 8192;
__device__ __forceinline__ void pre_ssp(const float* ssp, int orow, int t, float (&rsv)[16]) {
    if (t < 256) { const f32x4* p = (const f32x4*)(ssp + (size_t)(orow + t) * 16);
#pragma unroll
        for (int q = 0; q < 4; ++q) { const f32x4 v = p[q]; rsv[4 * q] = v[0]; rsv[4 * q + 1] = v[1]; rsv[4 * q + 2] = v[2]; rsv[4 * q + 3] = v[3]; } }
}
__device__ __forceinline__ void xchg_ssp(const float (&rsv)[16], int t, LAS unsigned char* lds) {
    LAS float* rsl = (LAS float*)(lds + RSL_OFF);
    if (t < 256) { const float s = (((rsv[0] + rsv[1]) + (rsv[2] + rsv[3])) + ((rsv[4] + rsv[5]) + (rsv[6] + rsv[7]))) + (((rsv[8] + rsv[9]) + (rsv[10] + rsv[11])) + ((rsv[12] + rsv[13]) + (rsv[14] + rsv[15])));
        rsl[t] = 1.0f / sqrtf(s * (1.0f / 1024.0f) + EPS); }
    asm volatile("s_waitcnt lgkmcnt(0)" ::: "memory"); __builtin_amdgcn_s_barrier(); asm volatile("" ::: "memory");
}
template <int MODE> struct EpiStore {
    static constexpr bool PERM = true, COLS64 = true;
    bf16_t* O; int ldc; const float* ssp; float cscale; unsigned* nrm;
    static constexpr bool HAS_PRE = true;
    __device__ __forceinline__ void pre(const Unit& u, int t, float (&rsv)[16]) const { if (ssp) pre_ssp(ssp, u.orow, t, rsv); }
    __device__ __forceinline__ void operator()(f32x4 (&acc)[2][2][4][2], const Unit& u, int wr, int wc, int fr, int fq, LAS unsigned char* lds, const float (&rsv)[16], int t) const {
        const int row0 = u.orow + wr * 64 + fr, col0 = u.ocol + wc * 64 + 8 * fq;
        if (ssp) xchg_ssp(rsv, t, lds);
        const LAS float* rsl = (const LAS float*)(lds + RSL_OFF) + wr * 64 + fr;
        float cs = 1.f; bool gel = false;
        if (MODE == 0) cs = cscale;
        if (MODE == 1) { gel = u.tag < 4; if (u.tag == 4 || u.tag == 5) cs = cscale; }
        if (MODE == 2) { if (u.tag < 2) cs = cscale; }
        const bool trk = (MODE == 1 && u.tag >= 4 && u.tag < 8) || (MODE == 2 && u.tag < 4); float nmx0 = 0.f, nmx1 = 0.f;
#pragma unroll
        for (int ai = 0; ai < 2; ++ai)
#pragma unroll
            for (int m = 0; m < 4; ++m) {
                const int row = row0 + ai * HALF + m * 16;
                const float rs = (ssp ? rsl[ai * HALF + m * 16] : 1.f) * cs;
                bf16_t* rowp = O + (size_t)row * ldc + col0;
#pragma unroll
                for (int bj = 0; bj < 2; ++bj) {
                    f32x4 v0 = acc[ai][bj][m][0] * rs, v1 = acc[ai][bj][m][1] * rs;
                    if (MODE == 1) { if (gel) {
#pragma unroll
                        for (int e = 0; e < 4; ++e) { v0[e] = gelu_tanh(v0[e]); v1[e] = gelu_tanh(v1[e]); } } }
                    if (MODE == 1 || MODE == 2) { if (trk) { float sq = (v0[0] * v0[0] + v0[1] * v0[1]) + (v0[2] * v0[2] + v0[3] * v0[3]) + (v1[0] * v1[0] + v1[1] * v1[1]) + (v1[2] * v1[2] + v1[3] * v1[3]);
                        sq += __shfl_xor(sq, 16); sq += __shfl_xor(sq, 32); if (bj == 0) nmx0 = fmaxf(nmx0, sq); else nmx1 = fmaxf(nmx1, sq); } }
                    u32x4 w; w.x = cvt_pk_bf16(v0[0], v0[1]); w.y = cvt_pk_bf16(v0[2], v0[3]); w.z = cvt_pk_bf16(v1[0], v1[1]); w.w = cvt_pk_bf16(v1[2], v1[3]);
                    *(u32x4*)(rowp + bj * 32) = w; }
            }
        if (MODE == 1 || MODE == 2) { if (trk) {
#pragma unroll
            for (int o = 1; o < 16; o <<= 1) { nmx0 = fmaxf(nmx0, __shfl_xor(nmx0, o)); nmx1 = fmaxf(nmx1, __shfl_xor(nmx1, o)); }
            if (fr == 0 && fq == 0) { const int b = u.orow >> 13;
                if (MODE == 1) { const int kind = (u.tag - 4) >> 1, hd = 2 * ((u.tag - 4) & 1) + (wc >> 1);
                    unsigned* p = nrm + ((b * 2 + kind) * 4 + hd) * 4 + 2 * (wc & 1);
                    __hip_atomic_fetch_max(p, __float_as_uint(nmx0), __ATOMIC_RELAXED, __HIP_MEMORY_SCOPE_AGENT);
                    __hip_atomic_fetch_max(p + 1, __float_as_uint(nmx1), __ATOMIC_RELAXED, __HIP_MEMORY_SCOPE_AGENT); }
                else { const int kind = u.tag >> 1, br = u.tag & 1;
                    unsigned* p = nrm + ((((b * 2 + kind) * 2 + br) * 4 + wc) * 2);
                    __hip_atomic_fetch_max(p, __float_as_uint(nmx0), __ATOMIC_RELAXED, __HIP_MEMORY_SCOPE_AGENT);
                    __hip_atomic_fetch_max(p + 1, __float_as_uint(nmx1), __ATOMIC_RELAXED, __HIP_MEMORY_SCOPE_AGENT); } } } }
    }
};
struct EpiPart {
    static constexpr bool PERM = true, COLS64 = true;
    float* P;
    __device__ __forceinline__ void operator()(f32x4 (&acc)[2][2][4][2], const Unit& u, int wr, int wc, int fr, int fq, LAS unsigned char*) const {
        float* base = P + (size_t)u.tag * 65536 + (size_t)(wr * 64 + fr) * 256 + wc * 64 + 8 * fq;
#pragma unroll
        for (int ai = 0; ai < 2; ++ai)
#pragma unroll
            for (int m = 0; m < 4; ++m)
#pragma unroll
                for (int bj = 0; bj < 2; ++bj) { float* p = base + (size_t)(ai * HALF + m * 16) * 256 + bj * 32; *(f32x4*)p = acc[ai][bj][m][0]; *(f32x4*)(p + 4) = acc[ai][bj][m][1]; }
    }
};
struct EpiResid {
    static constexpr bool PERM = true, COLS64 = true;
    const float* xin; bf16_t* xb; float* ssp; float sc = 1.0f;
    __device__ __forceinline__ void operator()(f32x4 (&acc)[2][2][4][2], const Unit& u, int wr, int wc, int fr, int fq, LAS unsigned char*) const {
        const int row0 = u.orow + wr * 64 + fr, col0 = u.ocol + wc * 64 + 8 * fq;
#pragma unroll
        for (int ai = 0; ai < 2; ++ai)
#pragma unroll
            for (int m = 0; m < 4; ++m) {
                const int row = row0 + ai * HALF + m * 16; const size_t off = (size_t)row * D + col0; float sq = 0.f;
#pragma unroll
                for (int bj = 0; bj < 2; ++bj) {
                    f32x4 o0, o1;
                    if (xin) { o0 = *(const f32x4*)(xin + off + bj * 32); o1 = *(const f32x4*)(xin + off + bj * 32 + 4); }
                    else { const u32x4 q = *(const u32x4*)(xb + off + bj * 32); o0 = (f32x4){bflo(q.x), bfhi(q.x), bflo(q.y), bfhi(q.y)}; o1 = (f32x4){bflo(q.z), bfhi(q.z), bflo(q.w), bfhi(q.w)}; }
                    o0 = o0 + acc[ai][bj][m][0] * sc; o1 = o1 + acc[ai][bj][m][1] * sc;
                    u32x4 w; w.x = cvt_pk_bf16(o0[0], o0[1]); w.y = cvt_pk_bf16(o0[2], o0[3]); w.z = cvt_pk_bf16(o1[0], o1[1]); w.w = cvt_pk_bf16(o1[2], o1[3]);
                    *(u32x4*)(xb + off + bj * 32) = w;
                    sq += (o0[0] * o0[0] + o0[1] * o0[1]) + (o0[2] * o0[2] + o0[3] * o0[3]) + (o1[0] * o1[0] + o1[1] * o1[1]) + (o1[2] * o1[2] + o1[3] * o1[3]); }
                sq += __shfl_xor(sq, 16); sq += __shfl_xor(sq, 32);
                if (fq == 0) ssp[(size_t)row * 16 + u.tag * 4 + wc] = sq;
                if (m & 1) asm volatile("" ::: "memory");
            }
    }
};
template <bool OUT8> struct EpiSwiGLU {
    static constexpr bool PERM = true, COLS64 = false;
    bf16_t* O; int ldc; const float* ssp; const float* rsd;
    static constexpr bool HAS_PRE = true;
    __device__ __forceinline__ void pre(const Unit& u, int t, float (&rsv)[16]) const {
        if (ssp) { pre_ssp(ssp, u.orow, t, rsv); return; }
        const int wr = t >> 8, fr = t & 15; const int row0 = u.orow + wr * 64 + fr;
#pragma unroll
        for (int ai = 0; ai < 2; ++ai)
#pragma unroll
            for (int m = 0; m < 4; ++m) rsv[ai * 4 + m] = rsd[row0 + ai * HALF + m * 16];
    }
    __device__ __forceinline__ void operator()(f32x4 (&acc)[2][2][4][2], const Unit& u, int wr, int wc, int fr, int fq, LAS unsigned char* lds, const float (&rsv)[16], int t) const {
        const int row0 = u.orow + wr * 64 + fr, col0 = u.ocol + wc * 32 + 8 * fq;
        if (ssp) xchg_ssp(rsv, t, lds);
        const LAS float* rsl = (const LAS float*)(lds + RSL_OFF) + wr * 64 + fr;
#pragma unroll
        for (int ai = 0; ai < 2; ++ai)
#pragma unroll
            for (int m = 0; m < 4; ++m) {
                const int row = row0 + ai * HALF + m * 16;
                const float rs = ssp ? rsl[ai * HALF + m * 16] : rsv[ai * 4 + m]; const float c1 = -LOG2E * rs, c2 = rs * rs;
                f32x4 h0, h1;
                const f32x2 c1v = (f32x2){c1, c1}, c2v = (f32x2){c2, c2};
#pragma unroll
                for (int e = 0; e < 4; e += 2) {
#pragma unroll
                    for (int n = 0; n < 2; ++n) {
                        const f32x2 gg = (f32x2){acc[ai][0][m][n][e], acc[ai][0][m][n][e + 1]}, uu = (f32x2){acc[ai][1][m][n][e], acc[ai][1][m][n][e + 1]};
                        const f32x2 tt = gg * c1v; const f32x2 dd = (f32x2){fast_exp2(tt.x), fast_exp2(tt.y)} + (f32x2){1.0f, 1.0f};
                        const f32x2 hh = ((gg * uu) * c2v) * (f32x2){fast_rcp(dd.x), fast_rcp(dd.y)};
                        if (n == 0) { h0[e] = hh.x; h0[e + 1] = hh.y; } else { h1[e] = hh.x; h1[e + 1] = hh.y; } } }
                if constexpr (OUT8) { u32x2 w; w.x = pk4_fp8(h0[0], h0[1], h0[2], h0[3]); w.y = pk4_fp8(h1[0], h1[1], h1[2], h1[3]);
                    *(u32x2*)((unsigned char*)O + (size_t)u.orow * ldc + (size_t)(u.ocol >> 7) * 32768 + (row - u.orow) * 128 + (col0 - u.ocol)) = w; }
                else { u32x4 w; w.x = cvt_pk_bf16(h0[0], h0[1]); w.y = cvt_pk_bf16(h0[2], h0[3]); w.z = cvt_pk_bf16(h1[0], h1[1]); w.w = cvt_pk_bf16(h1[2], h1[3]);
                    *(u32x4*)(O + (size_t)row * ldc + col0) = w; }
            }
    }
};
struct EpiSoftmax {
    static constexpr bool PERM = true, COLS64 = true;
    bf16_t* O; int ldc; const float* ssp;
    static constexpr bool HAS_PRE = true;
    __device__ __forceinline__ void pre(const Unit& u, int t, float (&rsv)[16]) const { pre_ssp(ssp, u.orow, t, rsv); }
    __device__ __forceinline__ void operator()(f32x4 (&acc)[2][2][4][2], const Unit& u, int wr, int wc, int fr, int fq, LAS unsigned char* lds, const float (&rsv)[16], int t) const {
        LAS float* red1 = (LAS float*)(lds + EPI_OFF); LAS float* red2 = red1 + 1024;
        const int row0 = u.orow + wr * 64 + fr, col0 = u.ocol + wc * 64 + 8 * fq;
        xchg_ssp(rsv, t, lds);
        const LAS float* rsl = (const LAS float*)(lds + RSL_OFF) + wr * 64 + fr;
#pragma unroll
        for (int ai = 0; ai < 2; ++ai)
#pragma unroll
            for (int m = 0; m < 4; ++m) {
                const float rs = rsl[ai * HALF + m * 16]; float mx = -3.0e38f;
#pragma unroll
                for (int bj = 0; bj < 2; ++bj)
#pragma unroll
                    for (int n = 0; n < 2; ++n) { f32x4 v = acc[ai][bj][m][n] * rs; acc[ai][bj][m][n] = v; mx = fmaxf(mx, fmaxf(fmaxf(v[0], v[1]), fmaxf(v[2], v[3]))); }
                mx = fmaxf(mx, __shfl_xor(mx, 16)); mx = fmaxf(mx, __shfl_xor(mx, 32));
                if (fq == 0) red1[(ai * HALF + wr * 64 + m * 16 + fr) * 4 + wc] = mx;
            }
        asm volatile("s_waitcnt lgkmcnt(0)" ::: "memory"); __builtin_amdgcn_s_barrier(); asm volatile("" ::: "memory");
#pragma unroll
        for (int ai = 0; ai < 2; ++ai)
#pragma unroll
            for (int m = 0; m < 4; ++m) {
                const int tr = ai * HALF + wr * 64 + m * 16 + fr; const f32x4 q = *(LAS f32x4*)(red1 + tr * 4);
                const float mx = fmaxf(fmaxf(q[0], q[1]), fmaxf(q[2], q[3])); float s = 0.f;
#pragma unroll
                for (int bj = 0; bj < 2; ++bj)
#pragma unroll
                    for (int n = 0; n < 2; ++n) { f32x4 v = acc[ai][bj][m][n];
#pragma unroll
                        for (int e = 0; e < 4; ++e) { v[e] = fast_exp2(v[e] - mx); s += v[e]; }
                        acc[ai][bj][m][n] = v; }
                s += __shfl_xor(s, 16); s += __shfl_xor(s, 32);
                if (fq == 0) red2[tr * 4 + wc] = s;
            }
        asm volatile("s_waitcnt lgkmcnt(0)" ::: "memory"); __builtin_amdgcn_s_barrier(); asm volatile("" ::: "memory");
#pragma unroll
        for (int ai = 0; ai < 2; ++ai)
#pragma unroll
            for (int m = 0; m < 4; ++m) {
                const int tr = ai * HALF + wr * 64 + m * 16 + fr; const f32x4 q = *(LAS f32x4*)(red2 + tr * 4);
                const float inv = 1.0f / ((q[0] + q[1]) + (q[2] + q[3]));
                bf16_t* rowp = O + (size_t)(row0 + ai * HALF + m * 16) * ldc + col0;
#pragma unroll
                for (int bj = 0; bj < 2; ++bj) { const f32x4 v0 = acc[ai][bj][m][0] * inv, v1 = acc[ai][bj][m][1] * inv;
                    u32x4 w; w.x = cvt_pk_bf16(v0[0], v0[1]); w.y = cvt_pk_bf16(v0[2], v0[3]); w.z = cvt_pk_bf16(v1[0], v1[1]); w.w = cvt_pk_bf16(v1[2], v1[3]);
                    *(u32x4*)(rowp + bj * 32) = w; }
            }
    }
};

template <class T, class = void> struct has_pre { static constexpr bool value = false; };
template <class T> struct has_pre<T, decltype((void)T::HAS_PRE)> { static constexpr bool value = true; };
template <class Epi, class Sched, bool ALIGN_EPI, bool FP8 = false>
__device__ __forceinline__ void gemm_phase(LAS unsigned char* lds, const Gemm g, const Sched& S, const Epi& E) {
    int tid_ = threadIdx.x; asm volatile("" : "+v"(tid_));
    const int tid = tid_, wid = __builtin_amdgcn_readfirstlane(tid >> 6), lane = tid & 63, wr = wid >> 2, wc = wid & 3, fr = lane & 15, fq = lane >> 4;
    const int K = g.K, nt = K / BK;
    unsigned voffA[2], voffB[2];
#pragma unroll
    for (int i = 0; i < 2; ++i) { int R, C; stage_rc(tid * 16 + i * 8192, R, C); const int Rb = Epi::COLS64 ? (64 * (R >> 5) + perm32(R & 31)) : ((R & ~31) + perm32(R & 31));
        voffA[i] = (unsigned)(R * g.lda + C) * 2u; voffB[i] = (unsigned)(Rb * g.ldb + C) * 2u; }
    const size_t kstep = (size_t)(BK * 2), kstepA = g.ksA ? (size_t)g.ksA : kstep;
    const size_t hstepA = (size_t)HALF * g.lda * 2, hstepB = (size_t)(Epi::COLS64 ? 32 : HALF) * g.ldb * 2;
    const unsigned ldsw = (unsigned)wid * 1024u;
    const int aoff = lds_byte(wr * 64 + fr, fq * 8), boff = lds_byte(wc * 32 + fr, fq * 8);
#define PG8_SA(b, h) (((b) * 2 + (h)) * HTB)
#define PG8_SB(b, h) ((4 + (b) * 2 + (h)) * HTB)
#define PG8_STAGE(bufoff, gbase, voff) do { _Pragma("unroll") for (int _i = 0; _i < 2; ++_i) \
        __builtin_amdgcn_global_load_lds((const unsigned*)((const char*)(gbase) + (voff)[_i]), (LAS unsigned*)(lds + (bufoff) + ldsw + _i * 8192), 16, 0, 0); } while (0)
#define PG8_LDA(dst, b, h) do { _Pragma("unroll") for (int m = 0; m < 4; ++m) { if constexpr (FP8) { const u32x4 lo_ = *(const LAS u32x4*)(lds + PG8_SA(b, h) + aoff + m * 2048), hi_ = *(const LAS u32x4*)(lds + PG8_SA(b, h) + aoff + m * 2048 + 1024); \
            dst##8[m] = (v8i_t){(int)lo_.x, (int)lo_.y, (int)lo_.z, (int)lo_.w, (int)hi_.x, (int)hi_.y, (int)hi_.z, (int)hi_.w}; } \
        else { _Pragma("unroll") for (int k = 0; k < 2; ++k) dst[m][k] = *(const LAS bf16x8*)(lds + PG8_SA(b, h) + aoff + m * 2048 + k * 1024); } } } while (0)
#define PG8_LDB(dst, b, h) do { _Pragma("unroll") for (int n = 0; n < 2; ++n) { if constexpr (FP8) { const u32x4 lo_ = *(const LAS u32x4*)(lds + PG8_SB(b, h) + boff + n * 2048), hi_ = *(const LAS u32x4*)(lds + PG8_SB(b, h) + boff + n * 2048 + 1024); \
            dst##8[n] = (v8i_t){(int)lo_.x, (int)lo_.y, (int)lo_.z, (int)lo_.w, (int)hi_.x, (int)hi_.y, (int)hi_.z, (int)hi_.w}; } \
        else { _Pragma("unroll") for (int k = 0; k < 2; ++k) dst[n][k] = *(const LAS bf16x8*)(lds + PG8_SB(b, h) + boff + n * 2048 + k * 1024); } } } while (0)
#define PG8_MMA(ai, bj, At, Bt) do { __builtin_amdgcn_s_setprio(1); \
        if constexpr (FP8) { _Pragma("unroll") for (int m = 0; m < 4; ++m) _Pragma("unroll") for (int n = 0; n < 2; ++n) \
            asm volatile("v_mfma_f32_16x16x128_f8f6f4 %0, %1, %2, %0" : "+v"(acc[ai][bj][m][n]) : "v"(Bt##8[n]), "v"(At##8[m])); }   \
        else { _Pragma("unroll") for (int m = 0; m < 4; ++m) _Pragma("unroll") for (int n = 0; n < 2; ++n) _Pragma("unroll") for (int k = 0; k < 2; ++k) \
            acc[ai][bj][m][n] = __builtin_amdgcn_mfma_f32_16x16x32_bf16(Bt[n][k], At[m][k], acc[ai][bj][m][n], 0, 0, 0); } \
        __builtin_amdgcn_s_setprio(0); } while (0)
#define PG8_WAIT_V(n) asm volatile("s_waitcnt vmcnt(" #n ")" ::: "memory")
#define PG8_WAIT_L(n) asm volatile("s_waitcnt lgkmcnt(" #n ")" ::: "memory")
#define PG8_BAR __builtin_amdgcn_s_barrier()
#define PG8_SCHED __builtin_amdgcn_sched_barrier(0)
    Unit cur, nxt; int ui = 0;
    if (!S.next(0, cur)) return;
    f32x4 acc[2][2][4][2];
#pragma unroll
    for (int a = 0; a < 2; ++a)
#pragma unroll
        for (int b = 0; b < 2; ++b)
#pragma unroll
            for (int m = 0; m < 4; ++m)
#pragma unroll
                for (int n = 0; n < 2; ++n) acc[a][b][m][n] = (f32x4){0.f, 0.f, 0.f, 0.f};
    bf16x8 At[4][2], B0[2][2], B1[2][2]; v8i_t At8[4], B08[2], B18[2]; (void)At; (void)B0; (void)B1; (void)At8; (void)B08; (void)B18;
    const char* cA = cur.a; const char* cB = cur.b;
    float rsv[16] = {0.f, 0.f, 0.f, 0.f, 0.f, 0.f, 0.f, 0.f, 0.f, 0.f, 0.f, 0.f, 0.f, 0.f, 0.f, 0.f}; (void)rsv;
    if constexpr (has_pre<Epi>::value) E.pre(cur, tid, rsv);
    PG8_STAGE(PG8_SB(0, 0), cB, voffB); PG8_STAGE(PG8_SB(0, 1), cB + hstepB, voffB); PG8_STAGE(PG8_SA(0, 0), cA, voffA); PG8_STAGE(PG8_SA(0, 1), cA + hstepA, voffA);
    if (wr == 1) PG8_BAR;
    PG8_WAIT_V(2); PG8_BAR;
    PG8_STAGE(PG8_SB(1, 0), cB + kstep, voffB); PG8_STAGE(PG8_SA(1, 0), cA + kstepA, voffA); PG8_STAGE(PG8_SB(1, 1), cB + hstepB + kstep, voffB);
    PG8_WAIT_V(6); PG8_BAR;
    for (;;) {
        const bool has_next = S.next(ui + 1, nxt);
        const char* nA = has_next ? nxt.a : cA; const char* nB = has_next ? nxt.b : cB;
        for (int t = 0; t < nt; t += 2) {
            const bool last = (t == nt - 2);
            const char* a1 = cA + (size_t)(t + 1) * kstepA;
            const char* a2 = last ? nA : cA + (size_t)(t + 2) * kstepA; const char* b2 = last ? nB : cB + (size_t)(t + 2) * kstep;
            const char* a3 = a2 + kstepA; const char* b3 = b2 + kstep;
            PG8_LDB(B0, 0, 0); PG8_LDB(B1, 0, 1); PG8_SCHED; PG8_LDA(At, 0, 0); PG8_STAGE(PG8_SA(1, 1), a1 + hstepA, voffA);
            PG8_WAIT_V(8); PG8_WAIT_L(0); PG8_BAR; PG8_MMA(0, 0, At, B0); PG8_MMA(0, 1, At, B1); PG8_BAR; PG8_SCHED;
            PG8_LDA(At, 0, 1); PG8_STAGE(PG8_SB(0, 0), b2, voffB); PG8_STAGE(PG8_SB(0, 1), b2 + hstepB, voffB); PG8_STAGE(PG8_SA(0, 0), a2, voffA);
            PG8_WAIT_V(8); PG8_WAIT_L(0); PG8_BAR; PG8_MMA(1, 0, At, B0); PG8_MMA(1, 1, At, B1); PG8_BAR; PG8_SCHED;
            PG8_LDB(B0, 1, 0); PG8_LDB(B1, 1, 1); PG8_SCHED; PG8_LDA(At, 1, 0); PG8_STAGE(PG8_SA(0, 1), a2 + hstepA, voffA);
            PG8_WAIT_V(8); PG8_WAIT_L(0); PG8_BAR; PG8_MMA(0, 0, At, B0); PG8_MMA(0, 1, At, B1); PG8_BAR; PG8_SCHED;
            PG8_LDA(At, 1, 1); PG8_STAGE(PG8_SB(1, 0), b3, voffB); PG8_STAGE(PG8_SB(1, 1), b3 + hstepB, voffB); PG8_STAGE(PG8_SA(1, 0), a3, voffA);
            PG8_WAIT_V(8); PG8_WAIT_L(0); PG8_BAR; PG8_MMA(1, 0, At, B0); PG8_MMA(1, 1, At, B1); PG8_BAR; PG8_SCHED;
        }
        if constexpr (FP8) asm volatile("s_nop 15\n\ts_nop 15" ::: "memory");
        if constexpr (ALIGN_EPI) { if (wr == 0) PG8_BAR; }
        {
            int t2 = threadIdx.x; asm volatile("" : "+v"(t2));
            const int wid2 = __builtin_amdgcn_readfirstlane(t2 >> 6), lane2 = t2 & 63;
            if constexpr (has_pre<Epi>::value) E(acc, cur, wid2 >> 2, wid2 & 3, lane2 & 15, lane2 >> 4, lds, rsv, t2);
            else E(acc, cur, wid2 >> 2, wid2 & 3, lane2 & 15, lane2 >> 4, lds);
        }
        if (!has_next) break;
#pragma unroll
        for (int a = 0; a < 2; ++a)
#pragma unroll
            for (int b = 0; b < 2; ++b)
#pragma unroll
                for (int m = 0; m < 4; ++m)
#pragma unroll
                    for (int n = 0; n < 2; ++n) acc[a][b][m][n] = (f32x4){0.f, 0.f, 0.f, 0.f};
        cur = nxt; cA = nA; cB = nB; ++ui;
        if constexpr (has_pre<Epi>::value) { int t3 = threadIdx.x; asm volatile("" : "+v"(t3)); E.pre(cur, t3, rsv); }
        if constexpr (ALIGN_EPI) { if (wr == 1) PG8_BAR; }
    }
    PG8_WAIT_V(0);
    if constexpr (!ALIGN_EPI) { if (wr == 0) PG8_BAR; }
    PG8_BAR;
#undef PG8_SA
#undef PG8_SB
#undef PG8_STAGE
#undef PG8_LDA
#undef PG8_LDB
#undef PG8_MMA
#undef PG8_WAIT_V
#undef PG8_WAIT_L
#undef PG8_BAR
#undef PG8_SCHED
}
}

struct Job { const float* src; const float* gain; bf16_t* dst; int ld, Kd, nnb, mode, start, pad; };
constexpr int NJOBS = 4 + 2 + 2 + 3 + 24;
__device__ __forceinline__ void tr_load(f32x4 (&v)[16], const float* W, int ld, int k0, int n0, int lane) {
    const int lr = lane >> 4, lc = (lane & 15) * 4;
#pragma unroll
    for (int i = 0; i < 16; ++i) v[i] = *(const GAS f32x4*)(W + (size_t)(k0 + 4 * i + lr) * ld + n0 + lc);
}
__device__ __forceinline__ void tr_emit(f32x4 (&v)[16], int k0, const float* gain, bf16_t* dst, int Kd, int drow0, LAS float* scr, int lane, bool f8) {
    const int lr = lane >> 4, lc = (lane & 15) * 4;
    if (gain) {
#pragma unroll
        for (int i = 0; i < 16; ++i) v[i] = v[i] * ((const GAS float*)gain)[k0 + 4 * i + lr];
    }
#pragma unroll
    for (int i = 0; i < 16; ++i) { LAS float* s = scr + (4 * i + lr) * 65 + lc; s[0] = v[i][0]; s[1] = v[i][1]; s[2] = v[i][2]; s[3] = v[i][3]; }
    LDS_WAIT(); asm volatile("" ::: "memory");
    const int c = lane >> 3, nl = lane & 7;
    if (f8) {
#pragma unroll
        for (int j = 0; j < 8; ++j) { const int n = nl + 8 * j; const LAS float* s = scr + (8 * c) * 65 + n;
            u32x2 o; o.x = pk4_fp8(s[0 * 65] * 64.f, s[1 * 65] * 64.f, s[2 * 65] * 64.f, s[3 * 65] * 64.f); o.y = pk4_fp8(s[4 * 65] * 64.f, s[5 * 65] * 64.f, s[6 * 65] * 64.f, s[7 * 65] * 64.f);
            *(GAS u32x2*)((unsigned char*)dst + (size_t)(drow0 + n) * Kd + k0 + 8 * c) = o; }
    } else {
#pragma unroll
    for (int j = 0; j < 8; ++j) { const int n = nl + 8 * j; const LAS float* s = scr + (8 * c) * 65 + n;
        u32x4 o; o.x = cvt_pk_bf16(s[0 * 65], s[1 * 65]); o.y = cvt_pk_bf16(s[2 * 65], s[3 * 65]); o.z = cvt_pk_bf16(s[4 * 65], s[5 * 65]); o.w = cvt_pk_bf16(s[6 * 65], s[7 * 65]);
        *(GAS u32x4*)(dst + (size_t)(drow0 + n) * Kd + k0 + 8 * c) = o; }
    }
    LDS_WAIT(); asm volatile("" ::: "memory");
}
__device__ __forceinline__ void tr_item(const float* W, int ld, int k0, int n0, const float* gain, bf16_t* dst, int Kd, int drow0, LAS float* scr, int lane, bool f8) {
    f32x4 v[16]; tr_load(v, W, ld, k0, n0, lane); tr_emit(v, k0, gain, dst, Kd, drow0, scr, lane, f8);
}

constexpr int MOE_ITEMS_GU = 8 * 2 * 16 * 56, MOE_ITEMS = MOE_ITEMS_GU + 8 * 56 * 16;
#ifndef FFN_D8
#define FFN_D8 1
#endif
#ifndef MK_Q1
#define MK_Q1 4
#endif
#ifndef MK_Q6
#define MK_Q6 4
#endif
struct MoeItem { const float* W; const float* gain; bf16_t* dst; int ld, k0, n0, Kd, drow0; };
__device__ __forceinline__ void moe_decode(int it, const float* wg, const float* wu, const float* wd, const float* gain, unsigned char* wgue, unsigned char* wde, MoeItem& m) {
    constexpr int ES = MOE_FP8 ? 1 : 2;
    if (it < MOE_ITEMS_GU) { const int e = it / 1792, r = it % 1792, up = r / 896, local = r % 896, kb = local % 16, nb = local / 16, n0 = nb * 64;
        m.W = (up ? wu : wg) + (size_t)e * D * FFE; m.ld = FFE; m.k0 = kb * 64; m.n0 = n0; m.gain = gain; m.dst = (bf16_t*)(wgue + (size_t)e * 2 * FFE * D * ES); m.Kd = D; m.drow0 = 256 * (n0 >> 7) + (up ? 128 : 0) + (n0 & 127); }
    else { const int i2 = it - MOE_ITEMS_GU, e = i2 / 896, local = i2 % 896, kb = local % 56, nb = local / 56;
        m.W = wd + (size_t)e * FFE * D; m.ld = D; m.k0 = kb * 64; m.n0 = nb * 64; m.gain = nullptr; m.dst = (bf16_t*)(wde + (size_t)e * D * FFE * ES); m.Kd = FFE; m.drow0 = nb * 64; }
}
__device__ __forceinline__ void moe_convert(gu32* ctr, int maxpulls, const float* wg, const float* wu, const float* wd, const float* gain, unsigned char* wgue, unsigned char* wde, LAS unsigned char* lds) {
    int t_ = threadIdx.x; asm volatile("" : "+v"(t_));
    const int wave = __builtin_amdgcn_readfirstlane(t_ >> 6), lane = t_ & 63;
    LAS float* scr = (LAS float*)(lds + wave * 16640); LAS int* sel = (LAS int*)(lds + 140 * 1024 + 64);
    constexpr int ES = MOE_FP8 ? 1 : 2;
    for (int p = 0; p < maxpulls; ++p) {
        __syncthreads();
        if (t_ == 0) sel[0] = (int)__hip_atomic_fetch_add(ctr, 8u, RLX_AGENT);
        __syncthreads();
        const int base = sel[0]; if (base >= MOE_ITEMS) break;
        const int it = base + wave;
        if (it < MOE_ITEMS_GU) { const int e = it / 1792, r = it % 1792, up = r / 896, local = r % 896, kb = local % 16, nb = local / 16, n0 = nb * 64;
            tr_item((up ? wu : wg) + (size_t)e * D * FFE, FFE, kb * 64, n0, gain, (bf16_t*)(wgue + (size_t)e * 2 * FFE * D * ES), D, 256 * (n0 >> 7) + (up ? 128 : 0) + (n0 & 127), scr, lane, MOE_FP8); }
        else if (it < MOE_ITEMS) { const int i2 = it - MOE_ITEMS_GU, e = i2 / 896, local = i2 % 896, kb = local % 56, nb = local / 56;
            tr_item(wd + (size_t)e * FFE * D, D, kb * 64, nb * 64, nullptr, (bf16_t*)(wde + (size_t)e * D * FFE * ES), FFE, nb * 64, scr, lane, MOE_FP8); }
    }
    __syncthreads();
}
#define MOE_CONVERT(n) moe_convert((gu32*)(ws + WS_CTL) + CW_MOEQ, (n), moe_w_gate, moe_w_up, moe_w_down, norm_ffn + D, (unsigned char*)WGUE, (unsigned char*)WDE, lds)

__device__ __forceinline__ int rel_bucket(int rel) {
    const int ret = rel > 0 ? 16 : 0; const int n = rel < 0 ? -rel : rel;
    if (n < 8) return ret + n;
    int large = 8 + (int)(logf((float)n / 8.0f) / 2.772588722239781f * 8.0f + 1e-4f);
    large = large < 15 ? large : 15;
    return ret + large;
}

namespace att {
typedef short s16x4 __attribute__((ext_vector_type(4)));
typedef float f32x16 __attribute__((ext_vector_type(16)));
typedef LAS unsigned char* lptr;
#define KSWZ(row, colB) ((row) * 256 + ((colB) ^ (((row) & 7) << 4)))
#define SBAR() __builtin_amdgcn_sched_barrier(0)
constexpr int SHM_T = 16384;
__device__ __forceinline__ int v_st(int k, int c) { const int kk = (k & ~0xC) | ((k & 4) << 1) | ((k & 8) >> 1); return ((kk >> 3) * 4 + (c >> 5)) * 512 + ((kk & 7) * 32 + (c & 31)) * 2; }
__device__ __forceinline__ int v_rd_base(int lane) { return ((lane & 3) << 3) | (((lane >> 2) & 3) << 6) | (((lane >> 4) & 1) << 5) | (((lane >> 5) & 1) << 8); }
constexpr int v_rd_off(int d0, int ks, int half) { return d0 * 512 + ks * 4096 + half * 2048; }
__device__ __forceinline__ int crow(int r, int hi) { return (r & 3) + 8 * (r >> 2) + 4 * hi; }
constexpr float THRL = 8.0f;
__device__ __forceinline__ bf16x8 kone_frag(int hi) { bf16x8 k = {0, 0, 0, 0, 0, 0, 0, 0}; k[0] = hi == 0 ? (short)0x3F80 : (short)0; return k; }
template <bool FIRST>
__device__ __forceinline__ void partialSM(f32x16& p0, f32x16& p1, float& mhat, float& l_reg, float& alpha, bf16x8& qx, int hi) {
    float a = fmaxf(fmaxf(p0[0], p0[1]), p0[2]), b = fmaxf(fmaxf(p1[0], p1[1]), p1[2]);
#pragma unroll
    for (int r = 3; r < 15; r += 2) { a = fmaxf(fmaxf(a, p0[r]), p0[r + 1]); b = fmaxf(fmaxf(b, p1[r]), p1[r + 1]); }
    float pmax = fmaxf(fmaxf(a, b), fmaxf(p0[15], p1[15]));
    { auto rr = __builtin_amdgcn_permlane32_swap(__float_as_uint(pmax), __float_as_uint(pmax), false, false); pmax = fmaxf(__uint_as_float(rr[0]), __uint_as_float(rr[1])); }
    alpha = 1.f;
    if (FIRST || __builtin_expect(__any(pmax > THRL), 0)) {
        const float d = FIRST ? (pmax > -1e30f ? pmax : 0.f) : fmaxf(pmax, 0.f);
        const unsigned mb = cvt_pk_bf16(mhat + d, 0.f) & 0xffffu; const float mn = __uint_as_float(mb << 16), delta = mn - mhat; mhat = mn;
#pragma unroll
        for (int r = 0; r < 16; ++r) { p0[r] -= delta; p1[r] -= delta; }
        if (!FIRST) { alpha = fast_exp2(-delta); l_reg *= alpha; }
        qx[0] = hi == 0 ? (short)(mb ^ 0x8000u) : (short)0;
    }
#pragma unroll
    for (int r = 0; r < 16; ++r) p0[r] = fast_exp2(p0[r]);
}
__device__ __forceinline__ void finishSM(f32x16& p0, f32x16& p1, float& l_reg, bf16x8& pa0, bf16x8& pa1, bf16x8& pa2, bf16x8& pa3) {
#pragma unroll
    for (int r = 0; r < 16; ++r) p1[r] = fast_exp2(p1[r]);
#define PR2(P, r) ((f32x2){P[r], P[(r) + 1]})
    f32x2 c0 = PR2(p0, 0) + PR2(p0, 2), c1 = PR2(p0, 4) + PR2(p0, 6), c2 = PR2(p0, 8) + PR2(p0, 10), c3 = PR2(p0, 12) + PR2(p0, 14);
    c0 += PR2(p1, 0); c1 += PR2(p1, 2); c2 += PR2(p1, 4); c3 += PR2(p1, 6); c0 += PR2(p1, 8); c1 += PR2(p1, 10); c2 += PR2(p1, 12); c3 += PR2(p1, 14);
#undef PR2
    const f32x2 cs = (c0 + c1) + (c2 + c3);
    float ps = cs.x + cs.y;
    { auto rr = __builtin_amdgcn_permlane32_swap(__float_as_uint(ps), __float_as_uint(ps), false, false); ps = __uint_as_float(rr[0]) + __uint_as_float(rr[1]); }
    l_reg += ps;
#define PK8(P, B_, OUT) do { u32x4 w = {cvt_pk_bf16(P[B_+0], P[B_+1]), cvt_pk_bf16(P[B_+2], P[B_+3]), cvt_pk_bf16(P[B_+4], P[B_+5]), cvt_pk_bf16(P[B_+6], P[B_+7])}; OUT = *reinterpret_cast<bf16x8*>(&w); } while (0)
    PK8(p0, 0, pa0); PK8(p0, 8, pa1); PK8(p1, 0, pa2); PK8(p1, 8, pa3);
#undef PK8
}
template <bool MASK>
__device__ __forceinline__ void fox_init(f32x16& p0, f32x16& p1, const LAS float* nb, int hi, int dq) {
    const LAS f32x4* nb_ = (const LAS f32x4*)(nb + 4 * hi); const float NEG = -__builtin_inff();
#pragma unroll
    for (int g = 0; g < 4; ++g) { const f32x4 b0 = nb_[2 * g], b1 = nb_[8 + 2 * g];
#pragma unroll
        for (int e = 0; e < 4; ++e) { const int c = e + 8 * g;
            p0[4 * g + e] = (MASK && dq - c < 0) ? NEG : b0[e]; p1[4 * g + e] = (MASK && dq - c - 32 < 0) ? NEG : b1[e]; } }
}
__device__ __forceinline__ void qkt128(f32x16& p0, f32x16& p1, lptr Kt, int r32, int hi, const bf16x8* qr, bf16x8 kone, bf16x8 qx) {
    lptr kb[4];
#pragma unroll
    for (int dd = 0; dd < 4; ++dd) kb[dd] = Kt + KSWZ(r32, (dd * 16 + hi * 8) * 2);
#pragma unroll
    for (int d0 = 0; d0 < 8; ++d0) { lptr a = kb[d0 & 3] + (d0 >> 2) * 128;
        const bf16x8 b0 = *(const LAS bf16x8*)(a); const bf16x8 b1 = *(const LAS bf16x8*)(a + 32 * 256);
        p0 = __builtin_amdgcn_mfma_f32_32x32x16_bf16(b0, qr[d0], p0, 0, 0, 0);
        p1 = __builtin_amdgcn_mfma_f32_32x32x16_bf16(b1, qr[d0], p1, 0, 0, 0); }
    p0 = __builtin_amdgcn_mfma_f32_32x32x16_bf16(kone, qx, p0, 0, 0, 0);
    p1 = __builtin_amdgcn_mfma_f32_32x32x16_bf16(kone, qx, p1, 0, 0, 0);
}
template <int VOFF>
__device__ __forceinline__ void pv_tile(f32x16* o, int vb, bf16x8 pa0, bf16x8 pa1, bf16x8 pa2, bf16x8 pa3) {
#define TRRD(dst, off) asm volatile("ds_read_b64_tr_b16 %0, %1 offset:%2" : "=&v"(dst) : "v"(vb), "i"(off) : "memory")
#define PV_D0(d0) do { s16x4 l0, l1, l2, l3, h0, h1, h2, h3; constexpr int b_ = VOFF + v_rd_off(d0, 0, 0); \
        TRRD(l0, b_); TRRD(h0, b_ + 2048); TRRD(l1, b_ + 4096); TRRD(h1, b_ + 6144); TRRD(l2, b_ + 8192); TRRD(h2, b_ + 10240); TRRD(l3, b_ + 12288); TRRD(h3, b_ + 14336); \
        asm volatile("s_waitcnt lgkmcnt(0)" ::: "memory"); SBAR(); \
        o[d0] = __builtin_amdgcn_mfma_f32_32x32x16_bf16(pa0, (bf16x8){l0[0], l0[1], l0[2], l0[3], h0[0], h0[1], h0[2], h0[3]}, o[d0], 0, 0, 0); \
        o[d0] = __builtin_amdgcn_mfma_f32_32x32x16_bf16(pa1, (bf16x8){l1[0], l1[1], l1[2], l1[3], h1[0], h1[1], h1[2], h1[3]}, o[d0], 0, 0, 0); \
        o[d0] = __builtin_amdgcn_mfma_f32_32x32x16_bf16(pa2, (bf16x8){l2[0], l2[1], l2[2], l2[3], h2[0], h2[1], h2[2], h2[3]}, o[d0], 0, 0, 0); \
        o[d0] = __builtin_amdgcn_mfma_f32_32x32x16_bf16(pa3, (bf16x8){l3[0], l3[1], l3[2], l3[3], h3[0], h3[1], h3[2], h3[3]}, o[d0], 0, 0, 0); } while (0)
    PV_D0(0); PV_D0(1); PV_D0(2); PV_D0(3);
#undef PV_D0
#undef TRRD
}

template <int VOFF>
__device__ __forceinline__ void pv_sm(f32x16* o, int vb, bf16x8 pa0, bf16x8 pa1, bf16x8 pa2, bf16x8 pa3, f32x16& p0, f32x16& p1, float& mhat, float& l_reg, float& alpha, bf16x8& qx, int hi) {
#define TRRD(dst, off) asm volatile("ds_read_b64_tr_b16 %0, %1 offset:%2" : "=&v"(dst) : "v"(vb), "i"(off) : "memory")
#define PV_D0(d0) do { s16x4 l0, l1, l2, l3, h0, h1, h2, h3; constexpr int b_ = VOFF + v_rd_off(d0, 0, 0); \
        TRRD(l0, b_); TRRD(h0, b_ + 2048); TRRD(l1, b_ + 4096); TRRD(h1, b_ + 6144); TRRD(l2, b_ + 8192); TRRD(h2, b_ + 10240); TRRD(l3, b_ + 12288); TRRD(h3, b_ + 14336); \
        asm volatile("s_waitcnt lgkmcnt(0)" ::: "memory"); SBAR(); \
        o[d0] = __builtin_amdgcn_mfma_f32_32x32x16_bf16(pa0, (bf16x8){l0[0], l0[1], l0[2], l0[3], h0[0], h0[1], h0[2], h0[3]}, o[d0], 0, 0, 0); \
        o[d0] = __builtin_amdgcn_mfma_f32_32x32x16_bf16(pa1, (bf16x8){l1[0], l1[1], l1[2], l1[3], h1[0], h1[1], h1[2], h1[3]}, o[d0], 0, 0, 0); \
        o[d0] = __builtin_amdgcn_mfma_f32_32x32x16_bf16(pa2, (bf16x8){l2[0], l2[1], l2[2], l2[3], h2[0], h2[1], h2[2], h2[3]}, o[d0], 0, 0, 0); \
        o[d0] = __builtin_amdgcn_mfma_f32_32x32x16_bf16(pa3, (bf16x8){l3[0], l3[1], l3[2], l3[3], h3[0], h3[1], h3[2], h3[3]}, o[d0], 0, 0, 0); } while (0)
    PV_D0(0);
    float a = fmaxf(fmaxf(p0[0], p0[1]), p0[2]);
#pragma unroll
    for (int r = 3; r < 15; r += 2) a = fmaxf(fmaxf(a, p0[r]), p0[r + 1]);
    PV_D0(1);
    float b = fmaxf(fmaxf(p1[0], p1[1]), p1[2]);
#pragma unroll
    for (int r = 3; r < 15; r += 2) b = fmaxf(fmaxf(b, p1[r]), p1[r + 1]);
    float pmax = fmaxf(fmaxf(a, b), fmaxf(p0[15], p1[15]));
    { auto rr = __builtin_amdgcn_permlane32_swap(__float_as_uint(pmax), __float_as_uint(pmax), false, false); pmax = fmaxf(__uint_as_float(rr[0]), __uint_as_float(rr[1])); }
    alpha = 1.f;
    if (__builtin_expect(__any(pmax > THRL), 0)) {
        const float d = fmaxf(pmax, 0.f);
        const unsigned mb = cvt_pk_bf16(mhat + d, 0.f) & 0xffffu; const float mn = __uint_as_float(mb << 16), delta = mn - mhat; mhat = mn;
#pragma unroll
        for (int r = 0; r < 16; ++r) { p0[r] -= delta; p1[r] -= delta; }
        alpha = fast_exp2(-delta); l_reg *= alpha;
        qx[0] = hi == 0 ? (short)(mb ^ 0x8000u) : (short)0;
    }
    PV_D0(2);
#pragma unroll
    for (int r = 0; r < 8; ++r) p0[r] = fast_exp2(p0[r]);
    PV_D0(3);
#pragma unroll
    for (int r = 8; r < 16; ++r) p0[r] = fast_exp2(p0[r]);
#undef PV_D0
#undef TRRD
}

template <int VOFF>
__device__ __forceinline__ void pv_exp(f32x16* o, int vb, bf16x8 pa0, bf16x8 pa1, bf16x8 pa2, bf16x8 pa3, f32x16& p0) {
#define TRRD(dst, off) asm volatile("ds_read_b64_tr_b16 %0, %1 offset:%2" : "=&v"(dst) : "v"(vb), "i"(off) : "memory")
#define PV_D0(d0) do { s16x4 l0, l1, l2, l3, h0, h1, h2, h3; constexpr int b_ = VOFF + v_rd_off(d0, 0, 0); \
        TRRD(l0, b_); TRRD(h0, b_ + 2048); TRRD(l1, b_ + 4096); TRRD(h1, b_ + 6144); TRRD(l2, b_ + 8192); TRRD(h2, b_ + 10240); TRRD(l3, b_ + 12288); TRRD(h3, b_ + 14336); \
        asm volatile("s_waitcnt lgkmcnt(0)" ::: "memory"); SBAR(); \
        o[d0] = __builtin_amdgcn_mfma_f32_32x32x16_bf16(pa0, (bf16x8){l0[0], l0[1], l0[2], l0[3], h0[0], h0[1], h0[2], h0[3]}, o[d0], 0, 0, 0); \
        o[d0] = __builtin_amdgcn_mfma_f32_32x32x16_bf16(pa1, (bf16x8){l1[0], l1[1], l1[2], l1[3], h1[0], h1[1], h1[2], h1[3]}, o[d0], 0, 0, 0); \
        o[d0] = __builtin_amdgcn_mfma_f32_32x32x16_bf16(pa2, (bf16x8){l2[0], l2[1], l2[2], l2[3], h2[0], h2[1], h2[2], h2[3]}, o[d0], 0, 0, 0); \
        o[d0] = __builtin_amdgcn_mfma_f32_32x32x16_bf16(pa3, (bf16x8){l3[0], l3[1], l3[2], l3[3], h3[0], h3[1], h3[2], h3[3]}, o[d0], 0, 0, 0); \
        _Pragma("unroll") for (int r = 4 * (d0); r < 4 * (d0) + 4; ++r) p0[r] = fast_exp2(p0[r]); } while (0)
    PV_D0(0); PV_D0(1); PV_D0(2); PV_D0(3);
#undef PV_D0
#undef TRRD
}

constexpr int FOX_NB = 131072, FOX_WS = 132096, FOX_ML = 134144;
#define WAIT_BAR() asm volatile("s_waitcnt vmcnt(0) lgkmcnt(0)\n\ts_barrier" ::: "memory")
__device__ __forceinline__ void fox_unit(const bf16_t* __restrict__ Zb, int h, int i, int t0, const float* __restrict__ cum, bf16_t* __restrict__ Yb, lptr lds) {
    int tid_ = threadIdx.x; asm volatile("" : "+v"(tid_));
    const int tid = tid_, wid = __builtin_amdgcn_readfirstlane(tid >> 6), lane = tid & 63, r32 = lane & 31, hi = lane >> 5;
    const int hb = wid >> 2, w4 = wid & 3, th = tid & 255;
    const int NT = i + 1 - t0, q0 = 128 * i;
    lptr V_lds = lds + hb * 65536; lptr K_lds = V_lds + 2 * SHM_T;
    LAS float* nbuf = (LAS float*)(lds + FOX_NB) + hb * 128;
    LAS float* wsf = (LAS float*)(lds + FOX_WS) + wid * 64; LAS float* li_l = wsf; LAS float* al_l = wsf + 32;
    const int qlo = q0 + 32 * w4, qm = qlo + r32 - 4 * hi;
    bf16x8 qr[8];
    { const bf16_t* Qw = Zb + (size_t)(qlo + r32) * EVEN_N + 1024 + h * 128 + hi * 8;
#pragma unroll
      for (int d0 = 0; d0 < 8; ++d0) qr[d0] = *(const bf16x8*)(Qw + d0 * 16); }
    const char* Kh = (const char*)(Zb + 1536 + h * 128); const char* Vh = (const char*)(Zb + 2048 + h * 128);
    const float cref = cum[q0];
    const int krow = 4 * w4 + (lane >> 4);
    const unsigned voffK = (unsigned)(krow * (EVEN_N * 2) + (((lane & 15) * 16) ^ ((krow & 7) << 4)));
    const int vrow = ((lane >> 2) & 3) + 4 * ((lane >> 4) & 1) + 8 * (w4 >> 1);
    const unsigned voffV = (unsigned)(vrow * (EVEN_N * 2) + (32 * (2 * (w4 & 1) + (lane >> 5)) + 8 * (lane & 3)) * 2);
    const int vb0 = (int)(uintptr_t)V_lds + v_rd_base(lane);
    float st_n = 0.f;
#define KBASE(t) ((2 * ((t) + t0) + hb) * 64)
#define DMA_K(t, bf) do { const char* tb_ = Kh + (size_t)KBASE(t) * (EVEN_N * 2); _Pragma("unroll") for (int j = 0; j < 4; ++j) \
        __builtin_amdgcn_global_load_lds((const unsigned*)(tb_ + (size_t)j * (16 * EVEN_N * 2) + voffK), (LAS unsigned*)(K_lds + (bf) * SHM_T + (j * 4 + w4) * 1024), 16, 0, 0); } while (0)
#define DMA_V(t, bf) do { const char* tb_ = Vh + (size_t)KBASE(t) * (EVEN_N * 2); _Pragma("unroll") for (int j = 0; j < 4; ++j) \
        __builtin_amdgcn_global_load_lds((const unsigned*)(tb_ + (size_t)j * (16 * EVEN_N * 2) + voffV), (LAS unsigned*)(V_lds + (bf) * SHM_T + (j * 4 + w4) * 1024), 16, 0, 0); } while (0)
#define NB_LOAD(t) do { if (th < 64) st_n = cum[KBASE(t) + th]; } while (0)
#define NB_WRITE(bf) do { if (th < 64) nbuf[(bf) * 64 + th] = (cref - st_n) * LOG2E; } while (0)
#define RESC(a) do { if (__any((a) < 1.f)) { if (hi == 0) al_l[r32] = (a); asm volatile("s_waitcnt lgkmcnt(0)" ::: "memory"); \
        _Pragma("unroll") for (int d_ = 0; d_ < 4; ++d_) _Pragma("unroll") for (int r = 0; r < 16; ++r) o[d_][r] *= al_l[crow(r, hi)]; } } while (0)
#define INIT(P0, P1, t, bf) do { const int kb_ = KBASE(t); if (kb_ + 63 > qlo) fox_init<true>(P0, P1, nbuf + (bf) * 64, hi, qm - kb_); else fox_init<false>(P0, P1, nbuf + (bf) * 64, hi, 0); } while (0)
    float m_reg = 0.f, l_reg = 0.f; f32x16 o[4] = {};
    f32x16 pA0, pA1, pB0, pB1; float alA, alB; bf16x8 pa0, pa1, pa2, pa3;
    const bf16x8 kone = kone_frag(hi); bf16x8 qx = {0, 0, 0, 0, 0, 0, 0, 0};
    DMA_K(0, 0); DMA_V(0, 0); NB_LOAD(0); NB_WRITE(0); WAIT_BAR();
    if (NT > 1) { DMA_K(1, 1); NB_LOAD(1); }
    INIT(pA0, pA1, 0, 0);
    SBAR(); qkt128(pA0, pA1, K_lds, r32, hi, qr, kone, qx);
    partialSM<true>(pA0, pA1, m_reg, l_reg, alA, qx, hi);
    if (NT > 1) NB_WRITE(1);
    WAIT_BAR();
    if (NT > 1) DMA_V(1, 1);
#define STEP(PX0, PX1, alX, PY0, PY1, alY, t, KB) do { \
        const bool more_ = (t) + 1 < NT; \
        if (more_) { DMA_K((t) + 1, 1 - (KB)); NB_LOAD((t) + 1); } \
        INIT(PX0, PX1, (t), (KB)); \
        SBAR(); qkt128(PX0, PX1, K_lds + (KB) * SHM_T, r32, hi, qr, kone, qx); \
        finishSM(PY0, PY1, l_reg, pa0, pa1, pa2, pa3); SBAR(); \
        pv_sm<(1 - (KB)) * SHM_T>(o, vb0, pa0, pa1, pa2, pa3, PX0, PX1, m_reg, l_reg, alX, qx, hi); \
        if (more_) NB_WRITE(1 - (KB)); \
        WAIT_BAR(); \
        if (more_) DMA_V((t) + 1, 1 - (KB)); \
        RESC(alX); } while (0)
    int t = 1;
    for (; t + 1 < NT; t += 2) {
        STEP(pB0, pB1, alB, pA0, pA1, alA, t, 1);
        STEP(pA0, pA1, alA, pB0, pB1, alB, t + 1, 0);
    }
    if ((NT & 1) == 0) {
        STEP(pB0, pB1, alB, pA0, pA1, alA, NT - 1, 1);
        finishSM(pB0, pB1, l_reg, pa0, pa1, pa2, pa3); SBAR(); pv_tile<SHM_T>(o, vb0, pa0, pa1, pa2, pa3);
    } else {
        finishSM(pA0, pA1, l_reg, pa0, pa1, pa2, pa3); SBAR(); pv_tile<0>(o, vb0, pa0, pa1, pa2, pa3);
    }
    WAIT_BAR();
    {
        int t2 = threadIdx.x; asm volatile("" : "+v"(t2));
        const int wid2 = __builtin_amdgcn_readfirstlane(t2 >> 6), lane2 = t2 & 63, r2 = lane2 & 31, hi2 = lane2 >> 5, hb2 = wid2 >> 2, w2 = wid2 & 3;
        LAS float* mrg = (LAS float*)(lds + 65536) + w2 * 4096; LAS float* mlB = (LAS float*)(lds + FOX_ML) + w2 * 64;
        LAS float* sc2 = (LAS float*)(lds + FOX_WS) + wid2 * 64;
        if (hb2 == 1) {
#pragma unroll
            for (int d0 = 0; d0 < 4; ++d0)
#pragma unroll
                for (int r = 0; r < 16; ++r) mrg[(d0 * 16 + r) * 64 + lane2] = o[d0][r];
            if (hi2 == 0) { mlB[r2] = m_reg; mlB[32 + r2] = l_reg; }
        }
        WAIT_BAR();
        if (hb2 == 0) {
            const float mb = mlB[r2], lb = mlB[32 + r2];
            const float Mx = fmaxf(m_reg, mb), fa = fast_exp2(m_reg - Mx), fb = fast_exp2(mb - Mx), inv = 1.0f / (l_reg * fa + lb * fb);
            if (hi2 == 0) { sc2[r2] = fa * inv; sc2[32 + r2] = fb * inv; }
            asm volatile("s_waitcnt lgkmcnt(0)" ::: "memory");
            LAS bf16_t* stg = (LAS bf16_t*)(lds + w2 * 8704);
#pragma unroll
            for (int r = 0; r < 16; ++r) { const int orow = crow(r, hi2); const float sa = sc2[orow], sb = sc2[32 + orow];
#pragma unroll
                for (int d0 = 0; d0 < 4; ++d0) { const float v = o[d0][r] * sa + mrg[(d0 * 16 + r) * 64 + lane2] * sb;
                    stg[orow * 136 + d0 * 32 + r2] = (bf16_t)(cvt_pk_bf16(v, 0.f) & 0xffffu); } }
            asm volatile("s_waitcnt lgkmcnt(0)" ::: "memory");
            bf16_t* yo = Yb + (size_t)(128 * i + 32 * w2) * D + 512 + h * 128;
#pragma unroll
            for (int it = 0; it < 8; ++it) { const int row = it * 4 + (lane2 >> 4), ch = lane2 & 15;
                const u32x4 v = *(const LAS u32x4*)((lptr)stg + row * 272 + ch * 16);
                *(u32x4*)(yo + (size_t)row * D + ch * 8) = v; }
        }
        WAIT_BAR();
    }
#undef KBASE
#undef DMA_K
#undef DMA_V
#undef NB_LOAD
#undef NB_WRITE
#undef RESC
#undef INIT
#undef STEP
}

constexpr int DF_LUT = 137216, DF_MRG = 69632, DF_WS = 135168;
#define KSWZ64(row, colB) ((row) * 128 + ((colB) ^ (((row) & 7) << 4)))
__device__ __forceinline__ void kload64(bf16x8* kf, lptr Kt, int r32, int hi) {
#pragma unroll
    for (int d0 = 0; d0 < 4; ++d0) { lptr a = Kt + KSWZ64(r32, d0 * 32 + hi * 16); kf[2 * d0] = *(const LAS bf16x8*)(a); kf[2 * d0 + 1] = *(const LAS bf16x8*)(a + 32 * 128); }
}
__device__ __forceinline__ void qkt64(f32x16& p0, f32x16& p1, const bf16x8* kf, const bf16x8* qr) {
#pragma unroll
    for (int d0 = 0; d0 < 4; ++d0) {
        p0 = __builtin_amdgcn_mfma_f32_32x32x16_bf16(kf[2 * d0], qr[d0], p0, 0, 0, 0);
        p1 = __builtin_amdgcn_mfma_f32_32x32x16_bf16(kf[2 * d0 + 1], qr[d0], p1, 0, 0, 0); }
}
__device__ __forceinline__ void diff_unit(const bf16_t* __restrict__ Zb, int h, int i, const float* __restrict__ relb, const float* __restrict__ gain, float lam, float post, bf16_t* __restrict__ Yb, lptr lds, const gu32* nrm  ) {
    int tid_ = threadIdx.x; asm volatile("" : "+v"(tid_));
    const int tid = tid_, wid = __builtin_amdgcn_readfirstlane(tid >> 6), lane = tid & 63, r32 = lane & 31, hi = lane >> 5;
    const int hb = wid >> 2, w4 = wid & 3;
    const int NT = 2 * (i + 1), q0 = 128 * i, qlo = q0 + 32 * w4, cq = qlo >> 6;
    lptr V_lds = lds; lptr K_lds = lds + 49152 + hb * 16384;
    LAS float* lut = (LAS float*)(lds + DF_LUT) + hb * 192;
    LAS float* wsf = (LAS float*)(lds + DF_WS) + wid * 64; LAS float* al_l = wsf + 32;
    float nB;
    { const gu32* np_ = nrm + ((0 * 2 + hb) * 4 + h) * 2; const gu32* nk_ = nrm + ((1 * 2 + hb) * 4 + h) * 2;
      const float nq = __uint_as_float(__hip_atomic_load(np_, RLX_AGENT)) + __uint_as_float(__hip_atomic_load(np_ + 1, RLX_AGENT));
      const float nk = __uint_as_float(__hip_atomic_load(nk_, RLX_AGENT)) + __uint_as_float(__hip_atomic_load(nk_ + 1, RLX_AGENT));
      const float lm = wave_max0((lane < 32) ? (relb[lane * 4 + h] - relb[15 * 4 + h]) * LOG2E : 0.f);
      nB = -(1.03f * sqrtf(nq) * sqrtf(nk) + lm + 0.5f); nB = __builtin_bit_cast(float, __builtin_amdgcn_readfirstlane(__builtin_bit_cast(int, nB))); }
    { const int li = w4 * 64 + lane; if (li < 192) lut[li] = (relb[rel_bucket(li - 128) * 4 + h] - relb[15 * 4 + h]) * LOG2E + nB; }
    bf16x8 qr[4];
    { const bf16_t* Qw = Zb + (size_t)(qlo + r32) * ODD_IN + hb * 256 + h * 64 + hi * 8;
#pragma unroll
      for (int d0 = 0; d0 < 4; ++d0) qr[d0] = *(const bf16x8*)(Qw + d0 * 16); }
    const char* Kh = (const char*)(Zb + 512 + hb * 256 + h * 64); const char* Vh = (const char*)(Zb + 1024 + h * 128);
    const int krow = 8 * w4 + (lane >> 3);
    const unsigned voffK = (unsigned)(krow * (ODD_IN * 2) + (((lane & 7) * 16) ^ ((krow & 7) << 4)));
    const int vrow = 16 * (wid >> 2) + ((lane >> 2) & 3) + 4 * ((lane >> 4) & 1) + 8 * ((wid >> 1) & 1);
    const unsigned voffV = (unsigned)(vrow * (ODD_IN * 2) + (32 * (2 * (wid & 1) + (lane >> 5)) + 8 * (lane & 3)) * 2);
    const int vb0 = (int)(uintptr_t)V_lds + v_rd_base(lane);
    const int lbase = 128 - qlo - r32 + 4 * hi;
#define DMA_K(t, bf) do { const char* tb_ = Kh + (size_t)(t) * (64 * ODD_IN * 2); _Pragma("unroll") for (int j = 0; j < 2; ++j) \
        __builtin_amdgcn_global_load_lds((const unsigned*)(tb_ + (size_t)j * (32 * ODD_IN * 2) + voffK), (LAS unsigned*)(K_lds + (bf) * 8192 + (j * 4 + w4) * 1024), 16, 0, 0); } while (0)
#define DMA_V(t, bf) do { const char* tb_ = Vh + (size_t)(t) * (64 * ODD_IN * 2); _Pragma("unroll") for (int j = 0; j < 2; ++j) \
        __builtin_amdgcn_global_load_lds((const unsigned*)(tb_ + (size_t)j * (32 * ODD_IN * 2) + voffV), (LAS unsigned*)(V_lds + (bf) * SHM_T + (j * 8 + wid) * 1024), 16, 0, 0); } while (0)
#define INIT(P0, P1, t) do { const int kb_ = (t) * 64; \
        if ((t) > cq) { const float ng_ = -__builtin_inff(); _Pragma("unroll") for (int r = 0; r < 16; ++r) { P0[r] = ng_; P1[r] = ng_; } } \
        else if (kb_ + 63 <= qlo - 128) { _Pragma("unroll") for (int r = 0; r < 16; ++r) { P0[r] = nB; P1[r] = nB; } } \
        else { const int ib_ = lbase + kb_; _Pragma("unroll") for (int r = 0; r < 16; ++r) { const int ix_ = ib_ + (r & 3) + 8 * (r >> 2); P0[r] = lut[ix_ < 0 ? 0 : ix_]; P1[r] = lut[ix_ + 32 < 0 ? 0 : ix_ + 32]; } } } while (0)
    float l_reg = 0.f; f32x16 o[4] = {};
    f32x16 pA0, pA1, pB0, pB1; bf16x8 pa0, pa1, pa2, pa3;
    DMA_K(0, 0); DMA_V(0, 0); WAIT_BAR();
    DMA_K(1, 1);
    bf16x8 kf[8];
    kload64(kf, K_lds, r32, hi); INIT(pA0, pA1, 0); SBAR(); qkt64(pA0, pA1, kf, qr);
#pragma unroll
    for (int r = 0; r < 16; ++r) pA0[r] = fast_exp2(pA0[r]);
    WAIT_BAR();
    DMA_V(1, 1);
#define SF(PX0, PX1, PY0, PY1, t, KB) do { kload64(kf, K_lds + (KB) * 8192, r32, hi); SBAR(); INIT(PX0, PX1, (t)); SBAR(); \
        qkt64(PX0, PX1, kf, qr); finishSM(PY0, PY1, l_reg, pa0, pa1, pa2, pa3); SBAR(); } while (0)
#define STEP(HB, PX0, PX1, PY0, PY1, t, KB) do { \
        const bool more_ = (t) + 1 < NT; const int vm1 = s1, vm2 = s1 == 0 ? 2 : s1 - 1;        \
        if ((HB) == 0) { if (more_) DMA_K((t) + 1, 1 - (KB)); SF(PX0, PX1, PY0, PY1, (t), (KB)); pv_exp<0>(o, vb0 + vm1 * SHM_T, pa0, pa1, pa2, pa3, PX0); } \
        else { if ((t) >= 2) pv_exp<0>(o, vb0 + vm2 * SHM_T, pa0, pa1, pa2, pa3, PY0); if (more_) DMA_K((t) + 1, 1 - (KB)); SF(PX0, PX1, PY0, PY1, (t), (KB)); } \
        WAIT_BAR(); \
        if (more_) DMA_V((t) + 1, vm2); \
        s1 = s1 == 2 ? 0 : s1 + 1; } while (0)
#define LOOP(HB) do { int s1 = 0;   int t = 1; \
        for (; t + 1 < NT; t += 2) { STEP(HB, pB0, pB1, pA0, pA1, t, 1); STEP(HB, pA0, pA1, pB0, pB1, t + 1, 0); } \
        STEP(HB, pB0, pB1, pA0, pA1, NT - 1, 1); \
        { const int vl = s1, vl2 = s1 == 0 ? 2 : s1 - 1;        \
          if ((HB) == 0) { finishSM(pB0, pB1, l_reg, pa0, pa1, pa2, pa3); SBAR(); pv_tile<0>(o, vb0 + vl * SHM_T, pa0, pa1, pa2, pa3); } \
          else { pv_exp<0>(o, vb0 + vl2 * SHM_T, pa0, pa1, pa2, pa3, pB0); finishSM(pB0, pB1, l_reg, pa0, pa1, pa2, pa3); SBAR(); pv_tile<0>(o, vb0 + vl * SHM_T, pa0, pa1, pa2, pa3); } } } while (0)
    if (hb == 0) LOOP(0); else LOOP(1);
    WAIT_BAR();
    {
        int t2 = threadIdx.x; asm volatile("" : "+v"(t2));
        const int wid2 = __builtin_amdgcn_readfirstlane(t2 >> 6), lane2 = t2 & 63, r2 = lane2 & 31, hi2 = lane2 >> 5, hb2 = wid2 >> 2, w2 = wid2 & 3;
        LAS float* mrg = (LAS float*)(lds + DF_MRG) + w2 * 4096; LAS float* sc2 = (LAS float*)(lds + DF_WS) + wid2 * 64;
        if (hi2 == 0) sc2[r2] = (hb2 ? lam : 1.0f) / l_reg;
        asm volatile("s_waitcnt lgkmcnt(0)" ::: "memory");
        if (hb2 == 1) {
#pragma unroll
            for (int r = 0; r < 16; ++r) { const float sb = sc2[crow(r, hi2)];
#pragma unroll
                for (int d0 = 0; d0 < 4; ++d0) mrg[(d0 * 16 + r) * 64 + lane2] = o[d0][r] * sb; }
        }
        WAIT_BAR();
        if (hb2 == 0) {
            LAS float* stg = (LAS float*)(lds + w2 * 16896);
#pragma unroll
            for (int r = 0; r < 16; ++r) { const int orow = crow(r, hi2); const float sa = sc2[orow];
#pragma unroll
                for (int d0 = 0; d0 < 4; ++d0) stg[orow * 132 + d0 * 32 + r2] = o[d0][r] * sa - mrg[(d0 * 16 + r) * 64 + lane2]; }
            asm volatile("s_waitcnt lgkmcnt(0)" ::: "memory");
            const int row = lane2 >> 1, hc = lane2 & 1;
            const LAS f32x4* sp = (const LAS f32x4*)(stg + row * 132 + hc * 64);
            f32x4 v[16]; float ss = 0.f;
#pragma unroll
            for (int k = 0; k < 16; ++k) { v[k] = sp[k]; ss += (v[k][0] * v[k][0] + v[k][1] * v[k][1]) + (v[k][2] * v[k][2] + v[k][3] * v[k][3]); }
            ss += __shfl_xor(ss, 1);
            const float rr = post / sqrtf(ss * (1.0f / 128.0f) + EPS);
            const f32x4* gp = (const f32x4*)(gain + h * 128 + hc * 64);
            bf16_t* yo = Yb + (size_t)(128 * i + 32 * w2 + row) * D + h * 128 + hc * 64;
#pragma unroll
            for (int k = 0; k < 8; ++k) { const f32x4 g0 = gp[2 * k], g1 = gp[2 * k + 1]; const f32x4 a = v[2 * k] * g0 * rr, b = v[2 * k + 1] * g1 * rr;
                u32x4 w; w.x = cvt_pk_bf16(a[0], a[1]); w.y = cvt_pk_bf16(a[2], a[3]); w.z = cvt_pk_bf16(b[0], b[1]); w.w = cvt_pk_bf16(b[2], b[3]);
                *(u32x4*)(yo + 8 * k) = w; }
        }
        WAIT_BAR();
    }
#undef DMA_K
#undef DMA_V
#undef INIT
#undef SF
#undef STEP
#undef LOOP
}

__device__ __forceinline__ void gmlp_unit(const bf16_t* __restrict__ Zb  , int gp, const float* __restrict__ Wg, const float* __restrict__ bs, const float* __restrict__ vgain, bf16_t* __restrict__ Yb, lptr lds) {
    int tid_ = threadIdx.x; asm volatile("" : "+v"(tid_));
    const int tid = tid_, wid = __builtin_amdgcn_readfirstlane(tid >> 6), lane = tid & 63, r32 = lane & 31, hi = lane >> 5;
    const int gs = wid >> 2, w4 = wid & 3, g = 2 * gp + gs;
    { const int sg = wid >> 2, gg = 2 * gp + sg, j0 = (wid & 3) * 32;
      unsigned wv[32];
#pragma unroll
      for (int rr = 0; rr < 32; ++rr) wv[rr] = *(const unsigned*)(Zb + (size_t)(j0 + rr) * EVEN_N + 512 + gg * 128 + 2 * lane);
      const f32x2 gn = *(const f32x2*)(vgain + gg * 128 + 2 * lane);
#pragma unroll
      for (int rr = 0; rr < 32; ++rr) { const int j = j0 + rr;
        const float a = bflo(wv[rr]), b = bfhi(wv[rr]); const float ss = wave_sum(a * a + b * b); const float r = 1.0f / sqrtf(ss * (1.0f / 128.0f) + EPS);
        *(LAS unsigned*)(lds + sg * 32768 + (j >> 6) * SHM_T + v_st(j & 63, 2 * lane)) = cvt_pk_bf16(a * r * gn[0], b * r * gn[1]); } }
    WAIT_BAR();
    f32x16 o[4] = {};
    const int vb = (int)(uintptr_t)(lds + gs * 32768) + v_rd_base(lane);
    const float* wrow = Wg + ((size_t)g * 128 + 32 * w4 + r32) * 128 + 8 * hi;
#define WFRAG(ks) ({ const f32x4 x0_ = *(const f32x4*)(wrow + 16 * (ks)), x1_ = *(const f32x4*)(wrow + 16 * (ks) + 4); \
        u32x4 w_ = {cvt_pk_bf16(x0_[0], x0_[1]), cvt_pk_bf16(x0_[2], x0_[3]), cvt_pk_bf16(x1_[0], x1_[1]), cvt_pk_bf16(x1_[2], x1_[3])}; *reinterpret_cast<bf16x8*>(&w_); })
    { const bf16x8 a0 = WFRAG(0), a1 = WFRAG(1), a2 = WFRAG(2), a3 = WFRAG(3);
      bf16x8 a4 = a0, a5 = a0, a6 = a0, a7 = a0; if (w4 >= 2) { a4 = WFRAG(4); a5 = WFRAG(5); a6 = WFRAG(6); a7 = WFRAG(7); }
      pv_tile<0>(o, vb, a0, a1, a2, a3);
      if (w4 >= 2) pv_tile<SHM_T>(o, vb, a4, a5, a6, a7); }
#undef WFRAG
    LAS bf16_t* stg = (LAS bf16_t*)(lds + 65536 + wid * 8704);
#pragma unroll
    for (int r = 0; r < 16; ++r) { const int orow = crow(r, hi); const float bb = bs[g * 128 + 32 * w4 + orow];
#pragma unroll
        for (int d0 = 0; d0 < 4; ++d0) stg[orow * 136 + d0 * 32 + r32] = (bf16_t)(cvt_pk_bf16(o[d0][r] + bb, 0.f) & 0xffffu); }
    asm volatile("s_waitcnt lgkmcnt(0)" ::: "memory");
    u32x4 uq[8];
#pragma unroll
    for (int it = 0; it < 8; ++it) uq[it] = *(const u32x4*)(Zb + (size_t)(32 * w4 + it * 4 + (lane >> 4)) * EVEN_N + g * 128 + (lane & 15) * 8);
#pragma unroll
    for (int it = 0; it < 8; ++it) { const int row = it * 4 + (lane >> 4), ch = lane & 15;
        const u32x4 mx = *(const LAS u32x4*)((lptr)stg + row * 272 + ch * 16);
        const u32x4 uu = uq[it];
        u32x4 w; w.x = cvt_pk_bf16(bflo(mx.x) * bflo(uu.x), bfhi(mx.x) * bfhi(uu.x)); w.y = cvt_pk_bf16(bflo(mx.y) * bflo(uu.y), bfhi(mx.y) * bfhi(uu.y));
        w.z = cvt_pk_bf16(bflo(mx.z) * bflo(uu.z), bfhi(mx.z) * bfhi(uu.z)); w.w = cvt_pk_bf16(bflo(mx.w) * bflo(uu.w), bfhi(mx.w) * bfhi(uu.w));
        *(u32x4*)(Yb + (size_t)(32 * w4 + row) * D + g * 128 + ch * 8) = w; }
    WAIT_BAR();
}
}

constexpr int NPHASE = 18;
struct Args { const float* in[32]; float* out; unsigned char* ws; int ph_lo, ph_hi; };

__global__ void __launch_bounds__(512, 2) mk_fwd(Args args) {
    extern __shared__ __attribute__((aligned(16))) unsigned char lds_raw[];
    LAS unsigned char* lds = (LAS unsigned char*)lds_raw;
    volatile LAS unsigned* MISC = (volatile LAS unsigned*)(lds + MISC_OFF);
    const int G = gridDim.x, bx = blockIdx.x, NGW = G * 8;
    for (int u = threadIdx.x; u < 64; u += 512) MISC[u] = 0u;
    __syncthreads();
#define KARG_T const __attribute__((address_space(4))) char*
#define PHASE_BEGIN() KARG_T ka = (KARG_T)__builtin_amdgcn_kernarg_segment_ptr(); asm volatile("" : "+s"(ka)); \
    unsigned char* ws = *(unsigned char* const __attribute__((address_space(4)))*)(ka + 264); \
    int tid = threadIdx.x; asm volatile("" : "+v"(tid)); const int lane = tid & 63, wave = __builtin_amdgcn_readfirstlane(tid >> 6); const int gw = bx * 8 + wave; (void)lane; (void)gw; (void)ws
#define ARG_IN(k) (*(const float* const __attribute__((address_space(4)))*)(ka + 8 * (k)))
#define ARG_OUT (*(float* const __attribute__((address_space(4)))*)(ka + 256))
#if !MK_PER_PHASE
    XcdBarrier bar = xcd_barrier_post((unsigned*)(args.ws + WS_CTL) + CW_BAR, MISC + 8);
#define GRID_BAR() xcd_barrier(bar)
#else
#define GRID_BAR() do {} while (0)
#endif
    const int lo = args.ph_lo, hi = args.ph_hi;
#ifndef MK_PHASE_MASK
#define MK_PHASE_MASK 0xFFFFFFFFu
#endif
#define IN(k) ((((MK_PHASE_MASK) >> (k)) & 1u) && lo <= (k) && (k) < hi)
#define SEAM(k) do { if (IN(k) && IN((k) + 1)) GRID_BAR(); } while (0)
#ifndef MK_DUP
#define MK_DUP (-1)
#endif
#define REPS(k) ((MK_DUP == (k)) ? 2 : 1)
#define DUP_BAR(k) do { if (rep_ + 1 < REPS(k)) GRID_BAR(); } while (0)

#define x_in ARG_IN(0)
#define mem_in ARG_IN(1)
#define norm_mix ARG_IN(2)
#define norm_mem_q ARG_IN(3)
#define norm_mem_kv ARG_IN(4)
#define norm_ffn ARG_IN(5)
#define norm_final ARG_IN(6)
#define even_w_in ARG_IN(7)
#define fox_b_f ARG_IN(8)
#define gmlp_v_gain ARG_IN(9)
#define gmlp_w_s ARG_IN(10)
#define gmlp_b_s ARG_IN(11)
#define even_w_out ARG_IN(12)
#define odd_w_in ARG_IN(13)
#define lq1 ARG_IN(14)
#define lk1 ARG_IN(15)
#define lq2 ARG_IN(16)
#define lk2 ARG_IN(17)
#define subln_gain ARG_IN(18)
#define conv_w ARG_IN(19)
#define odd_w_out ARG_IN(20)
#define rel_bias ARG_IN(21)
#define mem_w_q ARG_IN(22)
#define mem_w_kv ARG_IN(23)
#define mem_w_o ARG_IN(24)
#define ffn_w_gate ARG_IN(25)
#define ffn_w_up ARG_IN(26)
#define ffn_w_down ARG_IN(27)
#define router_w ARG_IN(28)
#define moe_w_gate ARG_IN(29)
#define moe_w_up ARG_IN(30)
#define moe_w_down ARG_IN(31)
#define XF ARG_OUT
#define CNT ((int*)(ws + WS_CNT))
#define TOKE ((unsigned*)(ws + WS_TOKE))
#define GATE ((float*)(ws + WS_GATE))
#define SLOT ((int*)(ws + WS_SLOT))
#define RS5 ((float*)(ws + WS_RS5))
#define RSS ((float*)(ws + WS_RSS))
#define FL ((float*)(ws + WS_FL))
#define CUM ((float*)(ws + WS_CUM))
#define SSP0 ((float*)(ws + WS_SSP))
#define SSP1 ((float*)(ws + WS_SSP + SSP_BYTES))
#define SSP2 ((float*)(ws + WS_SSP + 2 * SSP_BYTES))
#define SSP3 ((float*)(ws + WS_SSP + 3 * SSP_BYTES))
#define SSP4 ((float*)(ws + WS_SSP + 4 * SSP_BYTES))
#define WGUE ((bf16_t*)(ws + WS_WGUE))
#define WDE ((bf16_t*)(ws + WS_WDE))
#define YMOE ((bf16_t*)(ws + WS_YMOE))
#define WIN0 ((bf16_t*)(ws + WS_WIN0))
#define WOUT0 ((bf16_t*)(ws + WS_WOUT0))
#define WIN1 ((bf16_t*)(ws + WS_WIN1))
#define WOUT1 ((bf16_t*)(ws + WS_WOUT1))
#define WKV ((bf16_t*)(ws + WS_WKV))
#define WQG ((bf16_t*)(ws + WS_WQG))
#define WOT ((bf16_t*)(ws + WS_WOT))
#define WGU0 ((bf16_t*)(ws + WS_WGU0))
#define WD0 ((bf16_t*)(ws + WS_WD0))
#define MEMN ((bf16_t*)(ws + WS_MEMN))
#define KV ((bf16_t*)(ws + WS_KV))
#define AT ((bf16_t*)(ws + WS_AT))
#define BT ((bf16_t*)(ws + WS_BT))
#define XB ((bf16_t*)(ws + WS_XB))
#define Y ((bf16_t*)(ws + WS_Y))
#define Z ((bf16_t*)(ws + WS_Z))
#define AMOE ((bf16_t*)(ws + WS_AMOE))
#define HMOE ((bf16_t*)(ws + WS_HMOE))

    if (IN(0))
#pragma unroll 1
    for (int rep_ = 0; rep_ < REPS(0); ++rep_) {
        PHASE_BEGIN();
        LAS Job* jobs = (LAS Job*)(lds + JOB_OFF); LAS int* jtot = (LAS int*)(lds + JOB_OFF + NJOBS * 48);
        constexpr int NJ0 = 11;
        if (tid < NJ0) {
            Job jb; jb.pad = 0; jb.start = 0; const int j = tid;
            if (j == 0) { jb.src = even_w_in; jb.gain = norm_mix; jb.dst = WIN0; jb.ld = EVEN_IN; jb.Kd = D; jb.nnb = EVEN_N / 64; jb.mode = 0; }
            else if (j == 1) { jb.src = even_w_out; jb.gain = nullptr; jb.dst = WOUT0; jb.ld = D; jb.Kd = D; jb.nnb = D / 64; jb.mode = 0; }
            else if (j == 2) { jb.src = odd_w_in; jb.gain = norm_mix + D; jb.dst = WIN1; jb.ld = ODD_IN; jb.Kd = D; jb.nnb = ODD_IN / 64; jb.mode = 0; }
            else if (j == 3) { jb.src = odd_w_out; jb.gain = nullptr; jb.dst = WOUT1; jb.ld = D; jb.Kd = D; jb.nnb = D / 64; jb.mode = 0; }
            else if (j < 6) { const int l = j - 4; jb.src = mem_w_kv + (size_t)l * D * 2048; jb.gain = nullptr; jb.dst = WKV + (size_t)l * 2048 * D; jb.ld = 2048; jb.Kd = D; jb.nnb = 2048 / 64; jb.mode = 0; }
            else if (j < 8) { const int l = j - 6; jb.src = mem_w_o + (size_t)l * D * D; jb.gain = nullptr; jb.dst = WOT + (size_t)l * D * D; jb.ld = D; jb.Kd = D; jb.nnb = D / 64; jb.mode = 0; }
            else if (j == 8) { jb.src = ffn_w_gate; jb.gain = norm_ffn; jb.dst = WGU0; jb.ld = FF; jb.Kd = D; jb.nnb = FF / 64; jb.mode = 1; }
            else if (j == 9) { jb.src = ffn_w_up; jb.gain = norm_ffn; jb.dst = WGU0; jb.ld = FF; jb.Kd = D; jb.nnb = FF / 64; jb.mode = 2; }
            else if (j == 10) { jb.src = ffn_w_down; jb.gain = nullptr; jb.dst = WD0; jb.ld = D; jb.Kd = FF; jb.nnb = D / 64; jb.mode = 3; }
            else if (j < 19) { const int e = j - 11; jb.src = moe_w_gate + (size_t)e * D * FFE; jb.gain = norm_ffn + D; jb.dst = (bf16_t*)((unsigned char*)WGUE + (size_t)e * 2 * FFE * D * (MOE_FP8 ? 1 : 2)); jb.ld = FFE; jb.Kd = D; jb.nnb = FFE / 64; jb.mode = 1; }
            else if (j < 27) { const int e = j - 19; jb.src = moe_w_up + (size_t)e * D * FFE; jb.gain = norm_ffn + D; jb.dst = (bf16_t*)((unsigned char*)WGUE + (size_t)e * 2 * FFE * D * (MOE_FP8 ? 1 : 2)); jb.ld = FFE; jb.Kd = D; jb.nnb = FFE / 64; jb.mode = 2; }
            else { const int e = j - 27; jb.src = moe_w_down + (size_t)e * FFE * D; jb.gain = nullptr; jb.dst = (bf16_t*)((unsigned char*)WDE + (size_t)e * D * FFE * (MOE_FP8 ? 1 : 2)); jb.ld = D; jb.Kd = FFE; jb.nnb = D / 64; jb.mode = 4; }
            jobs[j].src = jb.src; jobs[j].gain = jb.gain; jobs[j].dst = jb.dst; jobs[j].ld = jb.ld; jobs[j].Kd = jb.Kd; jobs[j].nnb = jb.nnb; jobs[j].mode = jb.mode; jobs[j].start = 0; jobs[j].pad = 0;
        }
        __syncthreads();
        if (tid == 0) { int s = 0; for (int j = 0; j < NJ0; ++j) { const int nkb = (jobs[j].mode == 3 ? FF : (jobs[j].mode == 4 ? FFE : D)) / 64; jobs[j].start = s; s += nkb * jobs[j].nnb; } *jtot = s; }
        __syncthreads();
        {
            LAS float* scr = (LAS float*)(lds + wave * 16640);
            const int total = *jtot;
            for (int it = gw; it < total; it += NGW) {
                int j = 0;
                for (int q = 1; q < NJ0; ++q) if (jobs[q].start <= it) j = q;
                Job jb; jb.src = jobs[j].src; jb.gain = jobs[j].gain; jb.dst = jobs[j].dst; jb.ld = jobs[j].ld; jb.Kd = jobs[j].Kd; jb.nnb = jobs[j].nnb; jb.mode = jobs[j].mode; jb.start = jobs[j].start;
                const int local = it - jb.start, kb = local / jb.nnb, nb = local % jb.nnb, n0 = nb * 64;
                int drow0 = n0;
                if (jb.mode == 1) drow0 = 256 * (n0 >> 7) + (n0 & 127);
                if (jb.mode == 2) drow0 = 256 * (n0 >> 7) + 128 + (n0 & 127);
                tr_item(jb.src, jb.ld, kb * 64, n0, jb.gain, jb.dst, jb.Kd, drow0, scr, lane, FFN_D8 && jb.mode == 3);
            }
        }
        for (int i = bx * 512 + tid; i < 2 * D * D / 8; i += G * 512) {
            const int e0 = i * 8, l = e0 / (D * D), c = (e0 / D) % D; const float g = norm_mem_q[l * D + c];
            const f32x4 a = *(const f32x4*)(mem_w_q + e0) * g, b = *(const f32x4*)(mem_w_q + e0 + 4) * g;
            u32x4 o; o.x = cvt_pk_bf16(a[0], a[1]); o.y = cvt_pk_bf16(a[2], a[3]); o.z = cvt_pk_bf16(b[0], b[1]); o.w = cvt_pk_bf16(b[2], b[3]);
            *(u32x4*)(WQG + e0) = o;
        }
        for (int i = bx * 512 + tid; i < 8 * D; i += G * 512) { const int e = i >> 10, k = i & (D - 1); ((float*)(ws + WS_WRT))[i] = norm_ffn[D + k] * router_w[(size_t)k * 8 + e]; }
        {
            float wf[4][16];
            {
                LAS f32x4* wfl = (LAS f32x4*)(lds + 135 * 1024);
                __syncthreads();
                for (int k = tid; k < D; k += 512) wfl[k] = *(const f32x4*)(even_w_in + (size_t)k * EVEN_IN + EVEN_N) * norm_mix[k];
                __syncthreads();
#pragma unroll
                for (int j = 0; j < 4; ++j)
#pragma unroll
                    for (int e = 0; e < 4; ++e) { const f32x4 v = wfl[4 * lane + 256 * j + e]; wf[0][4 * j + e] = v[0]; wf[1][4 * j + e] = v[1]; wf[2][4 * j + e] = v[2]; wf[3][4 * j + e] = v[3]; }
            }
            for (int row = gw; row < M; row += NGW) {
                const f32x4* xr = (const f32x4*)(x_in + (size_t)row * D) + lane;
                f32x4 v[4]; float ss = 0.f, d0 = 0.f, d1 = 0.f, d2 = 0.f, d3 = 0.f;
#pragma unroll
                for (int j = 0; j < 4; ++j) { v[j] = xr[64 * j];
#pragma unroll
                    for (int e = 0; e < 4; ++e) { const float t = v[j][e]; ss += t * t; d0 += t * wf[0][4 * j + e]; d1 += t * wf[1][4 * j + e]; d2 += t * wf[2][4 * j + e]; d3 += t * wf[3][4 * j + e]; } }
                ss = wave_sum(ss); d0 = wave_sum(d0); d1 = wave_sum(d1); d2 = wave_sum(d2); d3 = wave_sum(d3);
                u32x2* o8 = (u32x2*)(XB + (size_t)row * D) + lane;
#pragma unroll
                for (int j = 0; j < 4; ++j) { u32x2 w; w.x = cvt_pk_bf16(v[j][0], v[j][1]); w.y = cvt_pk_bf16(v[j][2], v[j][3]); o8[64 * j] = w; }
                if (lane < 16) SSP0[(size_t)row * 16 + lane] = lane == 0 ? ss : 0.f;
                if (lane < 4) { const float r = 1.0f / sqrtf(ss * (1.0f / D) + EPS); const float dd = lane == 0 ? d0 : lane == 1 ? d1 : lane == 2 ? d2 : d3;
                    const float z = r * dd + fox_b_f[lane]; FL[(size_t)row * 4 + lane] = fminf(z, 0.f) - log1pf(expf(-fabsf(z))); }
            }
        }
        for (int R = gw; R < 2 * 512; R += NGW) {
            const int l = R / 512, rr = R % 512;
            const f32x4* xr = (const f32x4*)(mem_in + (size_t)rr * D) + lane; const f32x4* gr = (const f32x4*)(norm_mem_kv + l * D) + lane;
            f32x4 v[4]; float ss = 0.f;
#pragma unroll
            for (int j = 0; j < 4; ++j) { v[j] = xr[64 * j]; ss += (v[j][0] * v[j][0] + v[j][1] * v[j][1]) + (v[j][2] * v[j][2] + v[j][3] * v[j][3]); }
            ss = wave_sum(ss); const float r = 1.0f / sqrtf(ss * (1.0f / D) + EPS);
            u32x2* o8 = (u32x2*)(MEMN + (size_t)R * D) + lane;
#pragma unroll
            for (int j = 0; j < 4; ++j) { const f32x4 g = gr[64 * j]; u32x2 w; w.x = cvt_pk_bf16(v[j][0] * r * g[0], v[j][1] * r * g[1]); w.y = cvt_pk_bf16(v[j][2] * r * g[2], v[j][3] * r * g[3]); o8[64 * j] = w; }
        }
        __syncthreads();
        DUP_BAR(0);
    }
    SEAM(0);

    if (IN(1))
#pragma unroll 1
    for (int rep_ = 0; rep_ < REPS(1); ++rep_) {
        PHASE_BEGIN();
        {
            pg8::GridSched S; S.init(M / 256, EVEN_N / 256, G, bx, XB, (size_t)256 * D * 2, WIN0, (size_t)256 * D * 2, 256);
            pg8::EpiStore<1> E{Z, EVEN_N, SSP0, 0.08838834764831845f * LOG2E, (unsigned*)(ws + WS_CTL) + CW_NRM};
            pg8::gemm_phase<pg8::EpiStore<1>, pg8::GridSched, true>(lds, pg8::Gemm{D, D, D}, S, E);
        }
        {
            auto f = [=](int L, pg8::Unit& u) { const int l = L >> 4, pm = (L >> 3) & 1, pn = L & 7;
                u.a = (const char*)(MEMN + (size_t)(l * 512 + pm * 256) * D); u.b = (const char*)(WKV + (size_t)l * 2048 * D + (size_t)pn * 256 * D);
                u.orow = l * 512 + pm * 256; u.ocol = pn * 256; u.tag = 0; u.pad = 0; };
            pg8::ListSched<decltype(f)> S{32, G, G - 1 - bx, f};
            pg8::EpiStore<0> E{KV, 2048, nullptr, 1.0f, nullptr};
            pg8::gemm_phase<pg8::EpiStore<0>, pg8::ListSched<decltype(f)>, true>(lds, pg8::Gemm{D, D, D}, S, E);
        }
        if (bx >= G - 8 - 32 && bx < G - 32) {
            const int s = bx - (G - 8 - 32), b = s >> 2, h = s & 3;
            LAS float* part = (LAS float*)(lds + EPI_OFF);
            float v[16]; float run = 0.f;
#pragma unroll
            for (int i = 0; i < 16; ++i) { run += FL[(size_t)(b * SEQ + tid * 16 + i) * 4 + h]; v[i] = run; }
            float inc = run;
#pragma unroll
            for (int o = 1; o < 64; o <<= 1) { const float t = __shfl_up(inc, o); if (lane >= o) inc += t; }
            if (lane == 63) part[wave] = inc;
            __syncthreads();
            float base = inc - run;
            for (int w = 0; w < wave; ++w) base += part[w];
#pragma unroll
            for (int i = 0; i < 16; ++i) CUM[(size_t)s * SEQ + tid * 16 + i] = base + v[i];
            __syncthreads();
        }
        if (bx >= 128 && bx < G - 8 - 32) MOE_CONVERT(MK_Q1);
        DUP_BAR(1);
    }
    SEAM(1);

    if (IN(2))
#pragma unroll 1
    for (int rep_ = 0; rep_ < REPS(2); ++rep_) {
        PHASE_BEGIN();
        {
            auto f = [=](int L, pg8::Unit& u) { const int l = L >> 5, b = (L >> 4) & 1, h = (L >> 2) & 3, pn = L & 3;
                u.a = (const char*)(KV + (size_t)(l * 512 + b * 256) * 2048 + h * 256); u.b = (const char*)(WQG + (size_t)l * D * D + (size_t)pn * 256 * D + h * 256);
                u.orow = (l * 2 + b) * 1024 + h * 256; u.ocol = pn * 256; u.tag = 0; u.pad = 0; };
            pg8::ListSched<decltype(f)> S{64, G, bx, f};
            pg8::EpiStore<0> E{AT, D, nullptr, 0.0625f * LOG2E, nullptr};
            pg8::gemm_phase<pg8::EpiStore<0>, pg8::ListSched<decltype(f)>, true>(lds, pg8::Gemm{2048, D, 256}, S, E);
        }
        {
            auto f = [=](int L, pg8::Unit& u) { const int l = L >> 5, b = (L >> 4) & 1, h = (L >> 2) & 3, pm = L & 3;
                u.a = (const char*)(WOT + (size_t)l * D * D + (size_t)pm * 256 * D + h * 256); u.b = (const char*)(KV + (size_t)(l * 512 + b * 256) * 2048 + 1024 + h * 256);
                u.orow = (l * 2 + b) * 1024 + pm * 256; u.ocol = h * 256; u.tag = 0; u.pad = 0; };
            pg8::ListSched<decltype(f)> S{64, G, (bx + 64) % G, f};
            pg8::EpiStore<0> E{BT, D, nullptr, 1.0f, nullptr};
            pg8::gemm_phase<pg8::EpiStore<0>, pg8::ListSched<decltype(f)>, true>(lds, pg8::Gemm{D, 2048, 256}, S, E);
        }
        __syncthreads();
        for (int u = bx; u < 256; u += G) { const int bn = u >> 1, gp = u & 1;
            att::gmlp_unit(Z + (size_t)bn * 128 * EVEN_N, gp, gmlp_w_s, gmlp_b_s, gmlp_v_gain, Y + (size_t)bn * 128 * D, lds); }
        __syncthreads();
        {
            gu32* ctl = (gu32*)(ws + WS_CTL);
            LAS int* qsel = (LAS int*)(lds + 140 * 1024); LAS float* thrs = (LAS float*)(qsel + 4);
            __syncthreads();
            if (tid < 8) { const int b = tid >> 2, h = tid & 3; float nq = 0.f, nk = 0.f;
#pragma unroll
                for (int w = 0; w < 4; ++w) { nq += __uint_as_float(__hip_atomic_load(ctl + CW_NRM + ((b * 2 + 0) * 4 + h) * 4 + w, RLX_AGENT)); nk += __uint_as_float(__hip_atomic_load(ctl + CW_NRM + ((b * 2 + 1) * 4 + h) * 4 + w, RLX_AGENT)); }
                thrs[tid] = (38.0f + 2.0f * 1.02f * sqrtf(nq) * sqrtf(nk)) * 0.6931471805599453f; }
            for (;;) {
                __syncthreads();
                if (threadIdx.x < 64) { int ln = threadIdx.x; asm volatile("" : "+v"(ln));
                    const int qb = (bx + ln) & 7;
                    const unsigned head = ln < 8 ? __hip_atomic_load(ctl + CW_QCTR + 64 * qb, RLX_AGENT) : 64u;
                    const unsigned long long live = __ballot(head < 64u);
                    if (ln == 0) { int r = -1;
                        if (live) { const int bhq = (bx + (int)__builtin_ctzll(live)) & 7; const int k = (int)__hip_atomic_fetch_add(ctl + CW_QCTR + 64 * bhq, 1u, RLX_AGENT); r = k < 64 ? bhq * 64 + k : -2; }
                        qsel[0] = r; } }
                __syncthreads();
                const int sel = qsel[0];
                if (sel == -1) break;
                if (sel == -2) continue;
                const int bh = sel >> 6, k = sel & 63, b = bh >> 2, h = bh & 3;
                const float* cum = CUM + (size_t)bh * SEQ; const float thr = thrs[bh];
                const int i = 63 - k, q0 = 128 * i;
                const float c0 = cum[q0];
                int ln = threadIdx.x; asm volatile("" : "+v"(ln)); ln &= 63;
                const int T1 = ln, T2 = 64 + ln;
                const bool s1 = (T1 <= 2 * i + 1) && (cum[64 * T1 + 63] - c0 >= thr), s2 = (T2 <= 2 * i + 1) && (cum[64 * T2 + 63] - c0 >= thr);
                const int tlo = __popcll(__ballot(s1)) + __popcll(__ballot(s2));
                att::fox_unit(Z + (size_t)b * SEQ * EVEN_N, h, i, __builtin_amdgcn_readfirstlane(tlo >> 1), cum, Y + (size_t)b * SEQ * D, lds);
            }
        }
        DUP_BAR(2);
    }
    SEAM(2);

    if (IN(3))
#pragma unroll 1
    for (int rep_ = 0; rep_ < REPS(3); ++rep_) {
        PHASE_BEGIN();
        pg8::GridSched S; S.init(M / 256, 4, G, bx, Y, (size_t)256 * D * 2, WOUT0, (size_t)256 * D * 2, 256);
        pg8::EpiResid E{nullptr, XB, SSP1};
        pg8::gemm_phase<pg8::EpiResid, pg8::GridSched, true>(lds, pg8::Gemm{D, D, D}, S, E);
        DUP_BAR(3);
    }
    SEAM(3);
    if (IN(4))
#pragma unroll 1
    for (int rep_ = 0; rep_ < REPS(4); ++rep_) {
        PHASE_BEGIN();
        pg8::GridSched S; S.init(M / 256, 4, G, bx, XB, (size_t)256 * D * 2, AT, (size_t)256 * D * 2, 256); S.bSel = (size_t)D * D * 2; S.pmPerSel = 32;
        pg8::EpiSoftmax E{Y, D, SSP1};
        pg8::gemm_phase<pg8::EpiSoftmax, pg8::GridSched, true>(lds, pg8::Gemm{D, D, D}, S, E);
        DUP_BAR(4);
    }
    SEAM(4);
    if (IN(5))
#pragma unroll 1
    for (int rep_ = 0; rep_ < REPS(5); ++rep_) {
        PHASE_BEGIN();
        pg8::GridSched S; S.init(M / 256, 4, G, bx, Y, (size_t)256 * D * 2, BT, (size_t)256 * D * 2, 256); S.bSel = (size_t)D * D * 2; S.pmPerSel = 32;
        pg8::EpiResid E{nullptr, XB, SSP2};
        pg8::gemm_phase<pg8::EpiResid, pg8::GridSched, true>(lds, pg8::Gemm{D, D, D}, S, E);
        DUP_BAR(5);
    }
    SEAM(5);
    if (IN(6))
#pragma unroll 1
    for (int rep_ = 0; rep_ < REPS(6); ++rep_) {
        PHASE_BEGIN();
        pg8::GridSched S; S.init(M / 256, 2 * FF / 256, G, bx, XB, (size_t)256 * D * 2, WGU0, (size_t)256 * D * 2, 128);
        pg8::EpiSwiGLU<FFN_D8 != 0> E{Z, FF, SSP2, nullptr};
        pg8::gemm_phase<pg8::EpiSwiGLU<FFN_D8 != 0>, pg8::GridSched, true>(lds, pg8::Gemm{D, D, D}, S, E);
        if (bx >= 128) MOE_CONVERT(MK_Q6);
        DUP_BAR(6);
    }
    SEAM(6);
    if (IN(7))
#pragma unroll 1
    for (int rep_ = 0; rep_ < REPS(7); ++rep_) {
        PHASE_BEGIN();
#if FFN_D8
        pg8::GridSched S; S.init(M / 256, 4, G, bx, Z, (size_t)256 * FF, WD0, (size_t)256 * FF, 256);
        pg8::EpiResid E{nullptr, XB, SSP3, 1.0f / 64.0f};
        pg8::gemm_phase<pg8::EpiResid, pg8::GridSched, true, true>(lds, pg8::Gemm{64, FF / 2, FF / 2, 32768}, S, E);
#else
        pg8::GridSched S; S.init(M / 256, 4, G, bx, Z, (size_t)256 * FF * 2, WD0, (size_t)256 * FF * 2, 256);
        pg8::EpiResid E{nullptr, XB, SSP3};
        pg8::gemm_phase<pg8::EpiResid, pg8::GridSched, true>(lds, pg8::Gemm{FF, FF, FF}, S, E);
#endif
        DUP_BAR(7);
    }
    SEAM(7);
    if (IN(8))
#pragma unroll 1
    for (int rep_ = 0; rep_ < REPS(8); ++rep_) {
        PHASE_BEGIN();
        pg8::GridSched S; S.init(M / 256, ODD_IN / 256, G, bx, XB, (size_t)256 * D * 2, WIN1, (size_t)256 * D * 2, 256);
        pg8::EpiStore<2> E{Z, ODD_IN, SSP3, 0.125f * LOG2E, (unsigned*)(ws + WS_CTL) + CW_NRM2};
        pg8::gemm_phase<pg8::EpiStore<2>, pg8::GridSched, true>(lds, pg8::Gemm{D, D, D}, S, E);
        DUP_BAR(8);
    }
    SEAM(8);
    if (IN(9))
#pragma unroll 1
    for (int rep_ = 0; rep_ < REPS(9); ++rep_) {
        PHASE_BEGIN();
        const float lam_init = 0.8f - 0.6f * 0.7408182206817179f;
        float lam;
        { const float s1 = wave_sum(lq1[lane] * lk1[lane]), s2 = wave_sum(lq2[lane] * lk2[lane]); lam = expf(s1) - expf(s2) + lam_init;
          lam = __builtin_bit_cast(float, __builtin_amdgcn_readfirstlane(__builtin_bit_cast(int, lam))); }
        {
            const int c0 = lane * 8;
            float cw[3][8];
#pragma unroll
            for (int w = 0; w < 3; ++w) { const f32x4 a = *(const f32x4*)(conv_w + w * 512 + c0), b2 = *(const f32x4*)(conv_w + w * 512 + c0 + 4);
                cw[w][0] = a[0]; cw[w][1] = a[1]; cw[w][2] = a[2]; cw[w][3] = a[3]; cw[w][4] = b2[0]; cw[w][5] = b2[1]; cw[w][6] = b2[2]; cw[w][7] = b2[3]; }
            for (int blk = bx; blk < M / 64; blk += G) {
#pragma unroll 1
                for (int half = 0; half < 2; ++half) {
                    const int row0 = blk * 64 + wave * 8 + half * 4; const bool head = (row0 & (SEQ - 1)) == 0;
                    u32x4 hh[6], gc[6], gb[4];
#pragma unroll
                    for (int k = 0; k < 6; ++k) { const int r = row0 - 2 + k;
                        if (k >= 2 || !head) { hh[k] = *(const u32x4*)(Z + (size_t)r * ODD_IN + 1536 + c0); gc[k] = *(const u32x4*)(Z + (size_t)r * ODD_IN + 2560 + c0); }
                        else { hh[k] = (u32x4){0u, 0u, 0u, 0u}; gc[k] = (u32x4){0u, 0u, 0u, 0u}; } }
#pragma unroll
                    for (int k = 0; k < 4; ++k) gb[k] = *(const u32x4*)(Z + (size_t)(row0 + k) * ODD_IN + 2048 + c0);
                    float z[6][8];
#pragma unroll
                    for (int k = 0; k < 6; ++k) { z[k][0] = bflo(hh[k].x) * bflo(gc[k].x); z[k][1] = bfhi(hh[k].x) * bfhi(gc[k].x); z[k][2] = bflo(hh[k].y) * bflo(gc[k].y); z[k][3] = bfhi(hh[k].y) * bfhi(gc[k].y);
                        z[k][4] = bflo(hh[k].z) * bflo(gc[k].z); z[k][5] = bfhi(hh[k].z) * bfhi(gc[k].z); z[k][6] = bflo(hh[k].w) * bflo(gc[k].w); z[k][7] = bfhi(hh[k].w) * bfhi(gc[k].w); }
#pragma unroll
                    for (int k = 0; k < 4; ++k) {
                        const float gbf[8] = {bflo(gb[k].x), bfhi(gb[k].x), bflo(gb[k].y), bfhi(gb[k].y), bflo(gb[k].z), bfhi(gb[k].z), bflo(gb[k].w), bfhi(gb[k].w)};
                        float o[8];
#pragma unroll
                        for (int c = 0; c < 8; ++c) o[c] = gbf[c] * (cw[0][c] * z[k][c] + cw[1][c] * z[k + 1][c] + cw[2][c] * z[k + 2][c]);
                        u32x4 w; w.x = cvt_pk_bf16(o[0], o[1]); w.y = cvt_pk_bf16(o[2], o[3]); w.z = cvt_pk_bf16(o[4], o[5]); w.w = cvt_pk_bf16(o[6], o[7]);
                        *(u32x4*)(Y + (size_t)(row0 + k) * D + 512 + c0) = w; }
                }
            }
        }
        __syncthreads();
        for (int v = bx; v < 256; v += G) {
            const int bh = v & 7, p = v >> 3, b = bh >> 2, h = bh & 3;
#pragma unroll 1
            for (int pass = 0; pass < 2; ++pass)
                att::diff_unit(Z + (size_t)b * SEQ * ODD_IN, h, pass ? 63 - p : p, rel_bias, subln_gain, lam, 1.0f - lam_init, Y + (size_t)b * SEQ * D, lds, (const gu32*)(ws + WS_CTL) + CW_NRM2 + b * 32);
        }
        DUP_BAR(9);
    }
    SEAM(9);
    if (IN(10))
#pragma unroll 1
    for (int rep_ = 0; rep_ < REPS(10); ++rep_) {
        PHASE_BEGIN();
        pg8::GridSched S; S.init(M / 256, 4, G, bx, Y, (size_t)256 * D * 2, WOUT1, (size_t)256 * D * 2, 256);
        pg8::EpiResid E{nullptr, XB, SSP4};
        pg8::gemm_phase<pg8::EpiResid, pg8::GridSched, true>(lds, pg8::Gemm{D, D, D}, S, E);
        DUP_BAR(10);
    }
    SEAM(10);
    if (IN(11))
#pragma unroll 1
    for (int rep_ = 0; rep_ < REPS(11); ++rep_) {
        PHASE_BEGIN();
        pg8::GridSched S; S.init(M / 256, 4, G, bx, XB, (size_t)256 * D * 2, AT + (size_t)2 * D * D, (size_t)256 * D * 2, 256); S.bSel = (size_t)D * D * 2; S.pmPerSel = 32;
        pg8::EpiSoftmax E{Y, D, SSP4};
        pg8::gemm_phase<pg8::EpiSoftmax, pg8::GridSched, true>(lds, pg8::Gemm{D, D, D}, S, E);
        DUP_BAR(11);
    }
    SEAM(11);
    if (IN(12))
#pragma unroll 1
    for (int rep_ = 0; rep_ < REPS(12); ++rep_) {
        PHASE_BEGIN();
        pg8::GridSched S; S.init(M / 256, 4, G, bx, Y, (size_t)256 * D * 2, BT + (size_t)2 * D * D, (size_t)256 * D * 2, 256); S.bSel = (size_t)D * D * 2; S.pmPerSel = 32;
        pg8::EpiResid E{nullptr, XB, SSP0};
        pg8::gemm_phase<pg8::EpiResid, pg8::GridSched, true>(lds, pg8::Gemm{D, D, D}, S, E);
        DUP_BAR(12);
    }
    SEAM(12);
    if (IN(13))
#pragma unroll 1
    for (int rep_ = 0; rep_ < REPS(13); ++rep_) {
        PHASE_BEGIN();
        LAS int* sel = (LAS int*)lds;
        float wr_[8][16];
        {
            LAS float* wl = (LAS float*)(lds + 1024);
            const f32x4* src = (const f32x4*)(ws + WS_WRT);
#pragma unroll
            for (int q = 0; q < 4; ++q) *(LAS f32x4*)(wl + 4 * (tid + 512 * q)) = src[tid + 512 * q];
            __syncthreads();
#pragma unroll
            for (int x = 0; x < 8; ++x)
#pragma unroll
                for (int j = 0; j < 4; ++j) { const f32x4 v = *(const LAS f32x4*)(wl + x * D + 4 * lane + 256 * j); wr_[x][4 * j] = v[0]; wr_[x][4 * j + 1] = v[1]; wr_[x][4 * j + 2] = v[2]; wr_[x][4 * j + 3] = v[3]; }
        }
        f32x4 cv[16]; MoeItem cit; bool chas;
        {   LAS int* csel = (LAS int*)(lds + 140 * 1024 + 64);
            if (tid == 0) csel[0] = (int)__hip_atomic_fetch_add((gu32*)(ws + WS_CTL) + CW_MOEQ, 8u, RLX_AGENT);
            __syncthreads();
            const int it = csel[0] + wave; chas = it < MOE_ITEMS;
            if (chas) { moe_decode(it, moe_w_gate, moe_w_up, moe_w_down, norm_ffn + D, (unsigned char*)WGUE, (unsigned char*)WDE, cit); tr_load(cv, cit.W, cit.ld, cit.k0, cit.n0, lane); } }
        for (int wg = bx; wg < M / 64; wg += G) {
            __syncthreads();
            u32x2 xa[4], xb[4];
            { const u32x2* xr = (const u32x2*)(XB + (size_t)(wg * 64 + wave * 8) * D) + lane;
#pragma unroll
              for (int j = 0; j < 4; ++j) xa[j] = xr[64 * j]; }
#define ROUTE_ROW(XV, rr) do { const int lr = wave * 8 + (rr), row = wg * 64 + lr; \
                float ss = 0.f, lg[8] = {0.f, 0.f, 0.f, 0.f, 0.f, 0.f, 0.f, 0.f}; \
                _Pragma("unroll") for (int j = 0; j < 4; ++j) { const f32x4 v = (f32x4){bflo(XV[j].x), bfhi(XV[j].x), bflo(XV[j].y), bfhi(XV[j].y)}; \
                    _Pragma("unroll") for (int e = 0; e < 4; ++e) { const float t = v[e]; ss += t * t; \
                        _Pragma("unroll") for (int x = 0; x < 8; ++x) lg[x] += t * wr_[x][4 * j + e]; } } \
                ss = wave_sum(ss); \
                _Pragma("unroll") for (int x = 0; x < 8; ++x) lg[x] = wave_sum(lg[x]); \
                const float r = 1.0f / sqrtf(ss * (1.0f / D) + EPS); \
                int e0 = 0; float v0 = lg[0]; \
                _Pragma("unroll") for (int x = 1; x < 8; ++x) if (lg[x] > v0) { v0 = lg[x]; e0 = x; } \
                int e1 = -1; float v1 = -3.0e38f; \
                _Pragma("unroll") for (int x = 0; x < 8; ++x) if (x != e0 && lg[x] > v1) { v1 = lg[x]; e1 = x; } \
                if (lane == 0) { const float ga = 1.0f / (1.0f + expf((v1 - v0) * r));            \
                    GATE[(size_t)row * 2] = ga; GATE[(size_t)row * 2 + 1] = 1.0f - ga; RS5[row] = r; sel[lr * 2] = e0; sel[lr * 2 + 1] = e1; } } while (0)
#pragma unroll 1
            for (int rr = 0; rr < 8; rr += 2) {
                { const u32x2* xr = (const u32x2*)(XB + (size_t)(wg * 64 + wave * 8 + rr + 1) * D) + lane;
#pragma unroll
                  for (int j = 0; j < 4; ++j) xb[j] = xr[64 * j]; }
                ROUTE_ROW(xa, rr);
                if (rr + 2 < 8) { const u32x2* xr = (const u32x2*)(XB + (size_t)(wg * 64 + wave * 8 + rr + 2) * D) + lane;
#pragma unroll
                  for (int j = 0; j < 4; ++j) xa[j] = xr[64 * j]; }
                ROUTE_ROW(xb, rr + 1);
            }
#undef ROUTE_ROW
            __syncthreads();
            if (tid < 64) { const int e0 = sel[tid * 2], e1 = sel[tid * 2 + 1]; int r0 = 0, r1 = 0;
                for (int t = 0; t < tid; ++t) { const int a = sel[t * 2], b = sel[t * 2 + 1]; r0 += (a == e0) + (b == e0); r1 += (a == e1) + (b == e1); }
                TOKE[wg * 64 + tid] = (unsigned)e0 | ((unsigned)e1 << 8) | ((unsigned)r0 << 16) | ((unsigned)r1 << 24); }
            if (tid < 8) { int c = 0; for (int t = 0; t < 64; ++t) c += (sel[t * 2] == tid) + (sel[t * 2 + 1] == tid); CNT[wg * 8 + tid] = c; }
        }
        __syncthreads();
        if (chas) tr_emit(cv, cit.k0, cit.gain, cit.dst, cit.Kd, cit.drow0, (LAS float*)(lds + wave * 16640), lane, MOE_FP8);
        __syncthreads();
        DUP_BAR(13);
    }
    SEAM(13);
    if (IN(14))
#pragma unroll 1
    for (int rep_ = 0; rep_ < REPS(14); ++rep_) {
        PHASE_BEGIN();
        MOE_CONVERT(1 << 20);
        LAS int* tot = (LAS int*)lds; LAS int* offs = tot + 8; LAS int* base = offs + 8;
        for (int wg = bx; wg < M / 64; wg += G) {
            __syncthreads();
            {
                LAS int* ptot = base + 8; LAS int* pbas = ptot + 512;
                const int e = tid & 7, part = tid >> 3; int t = 0, bsum = 0;
#pragma unroll
                for (int q = 0; q < 4; ++q) { const int w = part * 4 + q; const int c = CNT[w * 8 + e]; t += c; if (w < wg) bsum += c; }
                ptot[part * 8 + e] = t; pbas[part * 8 + e] = bsum;
                __syncthreads();
                if (tid < 8) { int tt = 0, bb = 0; for (int p = 0; p < 64; ++p) { tt += ptot[p * 8 + tid]; bb += pbas[p * 8 + tid]; } tot[tid] = tt; base[tid] = bb; }
                __syncthreads();
            }
            if (tid == 0) { int o = 0; for (int e = 0; e < 8; ++e) { offs[e] = o; o += ((tot[e] + 255) >> 8) << 8; } }
            __syncthreads();
            if (wg == 0) {
                for (int e = 0; e < 8; ++e) { const int a = offs[e] + tot[e], bnd = offs[e] + (((tot[e] + 255) >> 8) << 8); for (int s = a + tid; s < bnd; s += 512) RSS[s] = 0.f; }
            }
            LAS int* pslot = base + 8 + 1024;
            if (tid < 128) { const int row = wg * 64 + (tid >> 1), k = tid & 1; const unsigned te = TOKE[row];
                const int e = (te >> (8 * k)) & 0xff, lr = (te >> (16 + 8 * k)) & 0xff; const int slot = offs[e] + base[e] + lr;
                pslot[tid] = slot; SLOT[row * 2 + k] = slot; RSS[slot] = RS5[row] * (1.0f / 64.0f); }
            __syncthreads();
#pragma unroll 1
            for (int t0 = wave * 16; t0 < wave * 16 + 16; t0 += 4) {
#if MOE_FP8
                u32x4 p[4], q[4];
#pragma unroll
                for (int j = 0; j < 4; ++j) { const u32x4* src = (const u32x4*)(XB + (size_t)(wg * 64 + ((t0 + j) >> 1)) * D) + 2 * lane; p[j] = src[0]; q[j] = src[1]; }
#pragma unroll
                for (int j = 0; j < 4; ++j) { const int slot = pslot[t0 + j];
                    u32x4 o; o.x = pk4_fp8(bflo(p[j].x), bfhi(p[j].x), bflo(p[j].y), bfhi(p[j].y)); o.y = pk4_fp8(bflo(p[j].z), bfhi(p[j].z), bflo(p[j].w), bfhi(p[j].w));
                    o.z = pk4_fp8(bflo(q[j].x), bfhi(q[j].x), bflo(q[j].y), bfhi(q[j].y)); o.w = pk4_fp8(bflo(q[j].z), bfhi(q[j].z), bflo(q[j].w), bfhi(q[j].w));
                    ((u32x4*)((unsigned char*)AMOE + (size_t)slot * D))[lane] = o; }
#else
                u32x4 p[4], q[4];
#pragma unroll
                for (int j = 0; j < 4; ++j) { const u32x4* src = (const u32x4*)(XB + (size_t)(wg * 64 + ((t0 + j) >> 1)) * D); p[j] = src[lane]; q[j] = src[lane + 64]; }
#pragma unroll
                for (int j = 0; j < 4; ++j) { u32x4* dst = (u32x4*)(AMOE + (size_t)pslot[t0 + j] * D); dst[lane] = p[j]; dst[lane + 64] = q[j]; }
#endif
            }
        }
        __syncthreads();
        DUP_BAR(14);
    }
    SEAM(14);
    int tpre[9];
    if (IN(15) || IN(16)) {
        PHASE_BEGIN();
        LAS int* tot = (LAS int*)(lds + EPI_OFF + 4096);
        __syncthreads();
        {   LAS int* ptot = tot + 16;
            const int e = tid & 7, part = tid >> 3; int t = 0;
#pragma unroll
            for (int q = 0; q < 4; ++q) t += CNT[(part * 4 + q) * 8 + e];
            ptot[part * 8 + e] = t;
            __syncthreads();
            if (tid < 8) { int tt = 0; for (int p = 0; p < 64; ++p) tt += ptot[p * 8 + tid]; tot[tid] = tt; }
            __syncthreads();
        }
        tpre[0] = 0;
#pragma unroll
        for (int e = 0; e < 8; ++e) tpre[e + 1] = tpre[e] + ((tot[e] + 255) >> 8);
#pragma unroll
        for (int e = 0; e < 9; ++e) tpre[e] = __builtin_amdgcn_readfirstlane(tpre[e]);
    }
    if (IN(15))
#pragma unroll 1
    for (int rep_ = 0; rep_ < REPS(15); ++rep_) {
        PHASE_BEGIN();
        constexpr int ES = MOE_FP8 ? 1 : 2;
        pg8::GridSched S; S.init(tpre[8], 2 * FFE / 256, G, bx, AMOE, (size_t)256 * D * ES, WGUE, (size_t)256 * D * ES, 128);
        S.byTable = true; S.bSel = (size_t)2 * FFE * D * ES; S.tp1 = tpre[1]; S.tp2 = tpre[2]; S.tp3 = tpre[3]; S.tp4 = tpre[4]; S.tp5 = tpre[5]; S.tp6 = tpre[6]; S.tp7 = tpre[7];
        pg8::EpiSwiGLU<MOE_FP8> E{HMOE, FFE, nullptr, RSS};
        pg8::gemm_phase<pg8::EpiSwiGLU<MOE_FP8>, pg8::GridSched, true, MOE_FP8>(lds, pg8::Gemm{D * ES / 2, D * ES / 2, D * ES / 2}, S, E);
        DUP_BAR(15);
    }
    SEAM(15);
    if (IN(16))
#pragma unroll 1
    for (int rep_ = 0; rep_ < REPS(16); ++rep_) {
        PHASE_BEGIN();
        constexpr int ES = MOE_FP8 ? 1 : 2;
        const int nmain = tpre[8] < 128 ? tpre[8] : 128;
        pg8::GridSched S; S.init(nmain, 4, G, bx, HMOE, (size_t)256 * FFE * ES, WDE, (size_t)256 * FFE * ES, 256);
        S.byTable = true; S.bSel = (size_t)D * FFE * ES; S.tp1 = tpre[1]; S.tp2 = tpre[2]; S.tp3 = tpre[3]; S.tp4 = tpre[4]; S.tp5 = tpre[5]; S.tp6 = tpre[6]; S.tp7 = tpre[7];
        pg8::EpiStore<0> E{YMOE, D, nullptr, 1.0f, nullptr};
        pg8::gemm_phase<pg8::EpiStore<0>, pg8::GridSched, true, MOE_FP8>(lds, pg8::Gemm{64, FFE * ES / 2, FFE * ES / 2, 32768}, S, E);
        {
            const int t1 = tpre[1], t2 = tpre[2], t3 = tpre[3], t4 = tpre[4], t5 = tpre[5], t6 = tpre[6], t7 = tpre[7];
            const unsigned char* hm = (const unsigned char*)HMOE; const unsigned char* wd = (const unsigned char*)WDE;
            auto f = [=](int L, pg8::Unit& u) { const int pmt = L / 28, r = L % 28, pn = r / 7, kc = r % 7, pm = 128 + pmt;
                const int e = (pm >= t1) + (pm >= t2) + (pm >= t3) + (pm >= t4) + (pm >= t5) + (pm >= t6) + (pm >= t7);
                u.a = (const char*)(hm + (size_t)pm * 256 * FFE + (size_t)kc * 4 * 32768); u.b = (const char*)(wd + (size_t)e * D * FFE + (size_t)pn * 256 * FFE + kc * 512);
                u.orow = 0; u.ocol = 0; u.tag = (pmt * 4 + pn) * 7 + kc; u.pad = 0; };
            pg8::ListSched<decltype(f)> S2{(tpre[8] - nmain) * 28, G, bx, f};
            pg8::EpiPart E2{(float*)(ws + WS_PART)};
            pg8::gemm_phase<pg8::EpiPart, pg8::ListSched<decltype(f)>, true, true>(lds, pg8::Gemm{64, FFE / 2, 256, 32768}, S2, E2);
        }
        DUP_BAR(16);
    }
    SEAM(16);
    if (IN(17))
#pragma unroll 1
    for (int rep_ = 0; rep_ < REPS(17); ++rep_) {
        PHASE_BEGIN();
        for (int row = gw; row < M; row += NGW) {
            const int s0 = SLOT[row * 2], s1 = SLOT[row * 2 + 1]; const float g0 = GATE[(size_t)row * 2] * (MOE_FP8 ? 1.0f / 64.0f : 1.0f), g1 = GATE[(size_t)row * 2 + 1] * (MOE_FP8 ? 1.0f / 64.0f : 1.0f);
            f32x4* xr = (f32x4*)(XF + (size_t)row * D) + lane; const u32x2* xq = (const u32x2*)(XB + (size_t)row * D) + lane;
            const u32x2* y0 = (const u32x2*)(YMOE + (size_t)s0 * D) + lane; const u32x2* y1 = (const u32x2*)(YMOE + (size_t)s1 * D) + lane;
            const f32x4* gr = (const f32x4*)norm_final + lane; const float* part = (const float*)(ws + WS_PART);
            f32x4 v[4]; float ss = 0.f;
            u32x2 xw[4], ra[4], rb[4];
#pragma unroll
            for (int j = 0; j < 4; ++j) { xw[j] = xq[64 * j]; ra[j] = y0[64 * j]; rb[j] = y1[64 * j]; }
#pragma unroll
            for (int j = 0; j < 4; ++j) { const f32x4 xv = (f32x4){bflo(xw[j].x), bfhi(xw[j].x), bflo(xw[j].y), bfhi(xw[j].y)};
                f32x4 ya = (f32x4){bflo(ra[j].x), bfhi(ra[j].x), bflo(ra[j].y), bfhi(ra[j].y)}, yb = (f32x4){bflo(rb[j].x), bfhi(rb[j].x), bflo(rb[j].y), bfhi(rb[j].y)};
                if (s0 >= 32768) {
                    const float* pp = part + ((size_t)(((s0 >> 8) - 128) * 4 + j) * 7) * 65536 + (size_t)(s0 & 255) * 256 + 4 * lane; ya = *(const f32x4*)pp;
#pragma unroll
                    for (int kc = 1; kc < 7; ++kc) ya = ya + *(const f32x4*)(pp + (size_t)kc * 65536); }
                if (s1 >= 32768) {
                    const float* pp = part + ((size_t)(((s1 >> 8) - 128) * 4 + j) * 7) * 65536 + (size_t)(s1 & 255) * 256 + 4 * lane; yb = *(const f32x4*)pp;
#pragma unroll
                    for (int kc = 1; kc < 7; ++kc) yb = yb + *(const f32x4*)(pp + (size_t)kc * 65536); }
                v[j][0] = xv[0] + g0 * ya[0] + g1 * yb[0]; v[j][1] = xv[1] + g0 * ya[1] + g1 * yb[1]; v[j][2] = xv[2] + g0 * ya[2] + g1 * yb[2]; v[j][3] = xv[3] + g0 * ya[3] + g1 * yb[3];
                ss += (v[j][0] * v[j][0] + v[j][1] * v[j][1]) + (v[j][2] * v[j][2] + v[j][3] * v[j][3]); }
            ss = wave_sum(ss); const float r = 1.0f / sqrtf(ss * (1.0f / D) + EPS);
#pragma unroll
            for (int j = 0; j < 4; ++j) { const f32x4 g = gr[64 * j]; xr[64 * j] = (f32x4){v[j][0] * r * g[0], v[j][1] * r * g[1], v[j][2] * r * g[2], v[j][3] * r * g[3]}; }
        }
    }
#undef IN
#undef SEAM
}

extern "C" void kernel_launch(void* const* d_in, const int* in_sizes, int n_in, void* d_out, int out_size, void* d_ws, size_t ws_size, hipStream_t stream) {
    static int grid = 0;
    if (grid == 0) {
        if (n_in != 32 || in_sizes[0] != M * D || out_size != M * D || ws_size < WS_END) {
            fprintf(stderr, "kernel_launch: unexpected shapes (n_in %d, in0 %d, out %d, ws %zu, need %zu); nothing launched\n", n_in, n_in > 0 ? in_sizes[0] : -1, out_size, ws_size, (size_t)WS_END); grid = -1; return; }
        int dev = 0, cus = 0;
        if (hipGetDevice(&dev) != hipSuccess || hipDeviceGetAttribute(&cus, hipDeviceAttributeMultiprocessorCount, dev) != hipSuccess) { grid = -1; return; }
        if (hipFuncSetAttribute((const void*)mk_fwd, hipFuncAttributeMaxDynamicSharedMemorySize, LDS_BYTES) != hipSuccess) { fprintf(stderr, "kernel_launch: hipFuncSetAttribute failed\n"); grid = -1; return; }
        int per_cu = 0;
        if (hipOccupancyMaxActiveBlocksPerMultiprocessor(&per_cu, (const void*)mk_fwd, 512, LDS_BYTES) != hipSuccess || per_cu < 1) fprintf(stderr, "kernel_launch: occupancy query says %d\n", per_cu);
        (void)hipGetLastError();
        grid = cus;
    }
    if (grid < 0) return;
    (void)hipMemsetAsync((char*)d_ws + WS_CTL, 0, CTL_ZERO_BYTES, stream);
    Args a{};
    for (int i = 0; i < 32; ++i) a.in[i] = (const float*)d_in[i];
    a.out = (float*)d_out; a.ws = (unsigned char*)d_ws;
#if MK_PER_PHASE
    for (int p = 0; p < NPHASE; ++p) { a.ph_lo = p; a.ph_hi = p + 1; hipLaunchKernelGGL(mk_fwd, dim3(grid), dim3(512), LDS_BYTES, stream, a); }
#else
    a.ph_lo = 0; a.ph_hi = NPHASE; hipLaunchKernelGGL(mk_fwd, dim3(grid), dim3(512), LDS_BYTES, stream, a);
#endif
    const hipError_t le = hipPeekAtLastError();
    if (le != hipSuccess) fprintf(stderr, "kernel_launch: launch failed: %s\n", hipGetErrorName(le));
}
```

```cpp
#include <hip/hip_runtime.h>
#include <cstdio>
#include <cstdint>

#ifndef MK_PER_PHASE
#define MK_PER_PHASE 0
#endif

#ifndef MOE_FP8
#define MOE_FP8 1
#endif
#define LAS __attribute__((address_space(3)))
#define GAS __attribute__((address_space(1)))
typedef unsigned short bf16_t;
typedef short bf16x8 __attribute__((ext_vector_type(8)));
typedef float f32x4 __attribute__((ext_vector_type(4)));
typedef float f32x2 __attribute__((ext_vector_type(2)));
typedef unsigned u32x4 __attribute__((ext_vector_type(4)));
typedef unsigned u32x2 __attribute__((ext_vector_type(2)));
typedef GAS unsigned gu32;
typedef int v8i_t __attribute__((ext_vector_type(8)));

constexpr int D = 1024, BATCH = 2, SEQ = 8192, M = BATCH * SEQ, MEMLEN = 256;
constexpr int EVEN_IN = 2564, EVEN_N = 2560, ODD_IN = 3072, FF = 2816, NE = 8, FFE = 3584;
constexpr float EPS = 1e-6f;
constexpr float LOG2E = 1.4426950408889634f;
constexpr int MOE_ROWS = 34816;
constexpr int MOE_TILES = MOE_ROWS / 256;

constexpr size_t MiB = 1u << 20;
constexpr size_t WS_CTL = 0, CTL_ZERO_BYTES = 64 * 1024;
constexpr size_t WS_CNT = 1 * MiB;
constexpr size_t WS_TOKE = WS_CNT + 8192;
constexpr size_t WS_GATE = WS_TOKE + (size_t)M * 4;
constexpr size_t WS_SLOT = WS_GATE + (size_t)M * 8;
constexpr size_t WS_RS5 = WS_SLOT + (size_t)M * 8;
constexpr size_t WS_RSS = WS_RS5 + (size_t)M * 4;
constexpr size_t WS_FL = WS_RSS + (size_t)MOE_ROWS * 4;
constexpr size_t WS_CUM = WS_FL + (size_t)M * 16;
constexpr size_t WS_WRT = WS_CUM + (size_t)8 * SEQ * 4;
constexpr size_t WS_SMALL_END = WS_WRT + (size_t)8 * D * 4;
static_assert(WS_SMALL_END <= 4 * MiB, "small region");
constexpr size_t WS_SSP = 4 * MiB;
constexpr size_t SSP_BYTES = (size_t)M * 16 * 4;
constexpr size_t WS_WGUE = 16 * MiB;
constexpr size_t WS_WDE = 128 * MiB;
constexpr size_t WS_YMOE = 16 * MiB;
constexpr size_t WS_WIN0 = 184 * MiB;
constexpr size_t WS_WOUT0 = 189 * MiB;
constexpr size_t WS_WIN1 = 191 * MiB;
constexpr size_t WS_WOUT1 = 197 * MiB;
constexpr size_t WS_WKV = 199 * MiB;
constexpr size_t WS_WQG = 207 * MiB;
constexpr size_t WS_WOT = 211 * MiB;
constexpr size_t WS_WGU0 = 215 * MiB;
constexpr size_t WS_WD0 = 226 * MiB;
constexpr size_t WS_MEMN = 232 * MiB;
constexpr size_t WS_KV = 234 * MiB;
constexpr size_t WS_AT = 238 * MiB;
constexpr size_t WS_BT = 246 * MiB;
constexpr size_t WS_XB = 256 * MiB;
constexpr size_t WS_Y = 288 * MiB;
constexpr size_t WS_Z = 320 * MiB;
constexpr size_t WS_AMOE = 184 * MiB;
constexpr size_t WS_HMOE = 288 * MiB;
static_assert(MOE_FP8, "the workspace map places the expert hidden activations for the fp8 path");
constexpr size_t WS_PART = 408 * MiB;
constexpr size_t WS_END = 490 * MiB;
static_assert(WS_WD0 + (size_t)D * FF * 2 <= WS_MEMN && WS_BT + 8 * MiB <= WS_XB && WS_Z + (size_t)M * 3072 * 2 <= WS_END, "map");
static_assert(WS_AMOE + (size_t)MOE_ROWS * D * 2 <= WS_HMOE && WS_YMOE + (size_t)MOE_ROWS * D * 2 <= WS_WDE, "map2");

constexpr int CW_BAR = 4096;
constexpr int CW_NRM = 8192;
constexpr int CW_MOEQ = 8256;
constexpr int CW_NRM2 = 9000;
constexpr int CW_QCTR = 8320;

constexpr int RING_BYTES = 131072;
constexpr int EPI_OFF = RING_BYTES;
constexpr int JOB_OFF = 140 * 1024;
constexpr int LDS_BYTES = 152 * 1024;
constexpr int MISC_OFF = LDS_BYTES - 256;

#define RLX_AGENT __ATOMIC_RELAXED, __HIP_MEMORY_SCOPE_AGENT
#define LDS_WAIT() asm volatile("s_waitcnt lgkmcnt(0)" ::: "memory")
#define VM_WAIT() asm volatile("s_waitcnt vmcnt(0)" ::: "memory")
__device__ __forceinline__ unsigned cvt_pk_bf16(float lo, float hi) { unsigned r; asm("v_cvt_pk_bf16_f32 %0, %1, %2" : "=v"(r) : "v"(lo), "v"(hi)); return r; }
__device__ __forceinline__ unsigned pk4_fp8(float a, float b, float c, float d) {
    int w = __builtin_amdgcn_cvt_pk_fp8_f32(a, b, 0, false); w = __builtin_amdgcn_cvt_pk_fp8_f32(c, d, w, true); return (unsigned)w; }
__device__ __forceinline__ float bf2f(bf16_t b) { return __uint_as_float((unsigned)b << 16); }
__device__ __forceinline__ float bflo(unsigned w) { return __uint_as_float(w << 16); }
__device__ __forceinline__ float bfhi(unsigned w) { return __uint_as_float(w & 0xffff0000u); }
__device__ __forceinline__ float wave_sum(float v) {
#define WS_DPP(ctrl, rmask) v += __builtin_bit_cast(float, __builtin_amdgcn_update_dpp(0, __builtin_bit_cast(int, v), (ctrl), (rmask), 0xF, true))
    WS_DPP(0xB1, 0xF);
    WS_DPP(0x4E, 0xF);
    WS_DPP(0x141, 0xF);
    WS_DPP(0x140, 0xF);
    WS_DPP(0x142, 0xA);
    WS_DPP(0x143, 0xC);
#undef WS_DPP
    return __builtin_bit_cast(float, __builtin_amdgcn_readlane(__builtin_bit_cast(int, v), 63));
}
__device__ __forceinline__ float wave_max0(float v) {
#define WM_DPP(ctrl, rmask) v = fmaxf(v, __builtin_bit_cast(float, __builtin_amdgcn_update_dpp(0, __builtin_bit_cast(int, v), (ctrl), (rmask), 0xF, true)))
    WM_DPP(0xB1, 0xF); WM_DPP(0x4E, 0xF); WM_DPP(0x141, 0xF); WM_DPP(0x140, 0xF); WM_DPP(0x142, 0xA); WM_DPP(0x143, 0xC);
#undef WM_DPP
    return __builtin_bit_cast(float, __builtin_amdgcn_readlane(__builtin_bit_cast(int, v), 63));
}
__device__ __forceinline__ float fast_exp2(float x) { return __builtin_amdgcn_exp2f(x); }
__device__ __forceinline__ float fast_rcp(float x) { return __builtin_amdgcn_rcpf(x); }
__device__ __forceinline__ float gelu_tanh(float x) {
    constexpr float CA = -2.0f * LOG2E * 0.7978845608028654f, CB = CA * 0.044715f;
    return x * fast_rcp(1.0f + fast_exp2(x * fmaf(x * x, CB, CA)));
}
__device__ __forceinline__ float silu_f(float x) { return x * fast_rcp(1.0f + fast_exp2(-LOG2E * x)); }

#define XB_TMO      128
#define XB_XCNT(j)  (256  + 64 * (j))
#define XB_XSUB(j)  (1280 + 64 * (j))
#define XB_XGEN(j)  (2304 + 64 * (j))
#define XB_TOP      3328
#define XB_TOPGEN   3392
#define XCD_BAR_WORDS 3456
#define XB_SPIN_CAP (1u << 18)
__device__ __forceinline__ unsigned xb_ld(unsigned* p)              { return __hip_atomic_load(p, __ATOMIC_RELAXED, __HIP_MEMORY_SCOPE_AGENT); }
__device__ __forceinline__ unsigned xb_add(unsigned* p, unsigned v) { return __hip_atomic_fetch_add(p, v, __ATOMIC_RELAXED, __HIP_MEMORY_SCOPE_AGENT); }
__device__ __forceinline__ unsigned xb_xcc_id() { return (unsigned)__builtin_amdgcn_s_getreg((3 << 11) | 20) & 0xFu; }
#define XB_SPIN(cond, bar) do { unsigned _sp = 0; while (cond) { __builtin_amdgcn_s_sleep(1); \
    if ((++_sp & 255u) == 0u) { if (xb_ld(&(bar)[XB_TMO])) break; if (_sp > XB_SPIN_CAP) { atomicAdd(&(bar)[XB_TMO], 1u); break; } } } } while (0)
struct XcdBarrier { unsigned* bar; unsigned x; volatile LAS unsigned* st; };
__device__ __forceinline__ XcdBarrier xcd_barrier_post(unsigned* bar, volatile LAS unsigned* st) {
    XcdBarrier b; b.bar = bar; b.x = xb_xcc_id(); b.st = st;
    if (threadIdx.x == 0) (void)xb_add(&bar[XB_XCNT(b.x)], 1u);
    return b;
}
__device__ __forceinline__ void xcd_barrier_complete(unsigned* bar, unsigned x, unsigned& nloc, unsigned& nx) {
    const unsigned G = gridDim.x * gridDim.y * gridDim.z;
    unsigned sum, cnt, mine, sp = 0u;
    for (;;) {
        sum = 0u; cnt = 0u; mine = 0u;
#pragma unroll
        for (unsigned j = 0; j < 16; ++j) { const unsigned c = xb_ld(&bar[XB_XCNT(j)]); sum += c; cnt += (c > 0u) ? 1u : 0u; mine = (j == x) ? c : mine; }
        if (sum == G) break;
        __builtin_amdgcn_s_sleep(1);
        if ((++sp & 255u) == 0u) { if (xb_ld(&bar[XB_TMO])) break; if (sp > XB_SPIN_CAP) { atomicAdd(&bar[XB_TMO], 1u); break; } }
    }
    nloc = mine > 0u ? mine : 1u; nx = cnt > 0u ? cnt : 1u;
}
__device__ __forceinline__ void xcd_barrier_arrive(const XcdBarrier& b) {
    asm volatile("s_waitcnt vmcnt(0)" ::: "memory");
    __syncthreads();
    if (threadIdx.x == 0) {
        unsigned* bar = b.bar;
        __builtin_amdgcn_s_waitcnt(0);
        unsigned nloc = b.st[0], nx = b.st[1];
        if (nloc == 0u) { xcd_barrier_complete(bar, b.x, nloc, nx); b.st[0] = nloc; b.st[1] = nx; }
        const unsigned k = b.st[2];
        const unsigned old = xb_add(&bar[XB_XSUB(b.x)], 1u);
        if (old + 1u == (k + 1u) * nloc) {
            __builtin_amdgcn_fence(__ATOMIC_RELEASE, "agent");
            asm volatile("s_waitcnt vmcnt(0)" ::: "memory");
            (void)xb_add(&bar[XB_TOP], 1u);
        }
        b.st[2] = k + 1u;
    }
}
__device__ __forceinline__ void xcd_barrier_wait(const XcdBarrier& b) {
    if (threadIdx.x == 0) {
        unsigned* bar = b.bar; const unsigned target = b.st[2] * b.st[1];
        XB_SPIN(xb_ld(&bar[XB_TOP]) < target, bar);
        __builtin_amdgcn_fence(__ATOMIC_ACQUIRE, "agent");
        asm volatile("s_waitcnt vmcnt(0)" ::: "memory");
    }
    __syncthreads();
}
__device__ __forceinline__ void xcd_barrier(const XcdBarrier& b) { xcd_barrier_arrive(b); xcd_barrier_wait(b); }

namespace pg8 {
constexpr int BM = 256, BK = 64, HALF = 128, HTB = HALF * BK * 2, STAGE_BYTES = 8 * HTB, NXCD = 8, WGM = 4;
__host__ __device__ __forceinline__ int lds_byte(int r, int c) { const int st = (r >> 4) * 2 + (c >> 5), rr = r & 15, cc = c & 31, ob = rr * 64 + cc * 2; return st * 1024 + (ob ^ (((ob >> 9) & 1) << 5)); }
__host__ __device__ __forceinline__ void stage_rc(int b, int& R, int& C) { const int st = b / 1024, sb = b % 1024, swz = sb ^ (((sb >> 9) & 1) << 5); R = (st >> 1) * 16 + swz / 64; C = (st & 1) * 32 + (swz % 64) / 2; }
__host__ __device__ __forceinline__ int perm32(int rho) { const int n = rho >> 4, i = rho & 15; return 8 * (i >> 2) + 4 * n + (i & 3); }

struct Unit { const char* a; const char* b; int orow, ocol, tag, pad; };
struct Gemm { int lda, ldb, K; int ksA = 0; };

struct GridSched {
    int nM, nN, nwg, G, c;
    const char* A; const char* B; size_t aTile, bTile, bSel; int pmPerSel; int ocolStep;
    int tp1, tp2, tp3, tp4, tp5, tp6, tp7; bool byTable;
    __device__ __forceinline__ void init(int nM_, int nN_, int G_, int c_, const void* A_, size_t aTile_, const void* B_, size_t bTile_, int ocolStep_) {
        nM = nM_; nN = nN_; nwg = nM * nN; G = G_; c = c_; A = (const char*)A_; B = (const char*)B_; aTile = aTile_; bTile = bTile_; bSel = 0; pmPerSel = 1 << 30; ocolStep = ocolStep_; byTable = false;
        tp1 = tp2 = tp3 = tp4 = tp5 = tp6 = tp7 = 0; }
    __device__ __forceinline__ bool next(int i, Unit& u) const {
        const long L = (long)i * G + c; if (L >= nwg) return false;
        int wgid = (int)L; { const int q = nwg / NXCD, r = nwg % NXCD, xcd = wgid % NXCD, off = wgid / NXCD; wgid = (xcd < r ? xcd * (q + 1) : r * (q + 1) + (xcd - r) * q) + off; }
        const int nig = WGM * nN, gid = wgid / nig, fm = gid * WGM, gsz = (nM - fm) < WGM ? (nM - fm) : WGM;
        const int pm = fm + ((wgid % nig) % gsz), pn = (wgid % nig) / gsz;
        int sel = pm / pmPerSel;
        if (byTable) sel = (pm >= tp1) + (pm >= tp2) + (pm >= tp3) + (pm >= tp4) + (pm >= tp5) + (pm >= tp6) + (pm >= tp7);
        u.a = A + (size_t)pm * aTile; u.b = B + (size_t)pn * bTile + (size_t)sel * bSel; u.orow = pm * 256; u.ocol = pn * ocolStep; u.tag = pn; u.pad = 0; return true;
    }
};
template <class F> struct ListSched {
    int n, G, c; F f;
    __device__ __forceinline__ bool next(int i, Unit& u) const { const long L = (long)i * G + c; if (L >= n) return false; f((int)L, u); return true; }
};

__device__ __forceinline__ float row_scale(const float* ssp, int row) {
    const f32x4* p = (const f32x4*)(ssp + (size_t)row * 16); const f32x4 a = p[0], b = p[1], c = p[2], d = p[3];
    const float s = ((a[0] + a[1]) + (a[2] + a[3])) + ((b[0] + b[1]) + (b[2] + b[3])) + ((c[0] + c[1]) + (c[2] + c[3])) + ((d[0] + d[1]) + (d[2] + d[3]));
    return 1.0f / sqrtf(s * (1.0f / 1024.0f) + EPS);
}
constexpr int RSL_OFF = EPI_OFF + 8192;
__device__ __forceinline__ void pre_ssp(const float* ssp, int orow, int t, float (&rsv)[16]) {
    if (t < 256) { const f32x4* p = (const f32x4*)(ssp + (size_t)(orow + t) * 16);
#pragma unroll
        for (int q = 0; q < 4; ++q) { const f32x4 v = p[q]; rsv[4 * q] = v[0]; rsv[4 * q + 1] = v[1]; rsv[4 * q + 2] = v[2]; rsv[4 * q + 3] = v[3]; } }
}
__device__ __forceinline__ void xchg_ssp(const float (&rsv)[16], int t, LAS unsigned char* lds) {
    LAS float* rsl = (LAS float*)(lds + RSL_OFF);
    if (t < 256) { const float s = (((rsv[0] + rsv[1]) + (rsv[2] + rsv[3])) + ((rsv[4] + rsv[5]) + (rsv[6] + rsv[7]))) + (((rsv[8] + rsv[9]) + (rsv[10] + rsv[11])) + ((rsv[12] + rsv[13]) + (rsv[14] + rsv[15])));
        rsl[t] = 1.0f / sqrtf(s * (1.0f / 1024.0f) + EPS); }
    asm volatile("s_waitcnt lgkmcnt(0)" ::: "memory"); __builtin_amdgcn_s_barrier(); asm volatile("" ::: "memory");
}
template <int MODE> struct EpiStore {
    static constexpr bool PERM = true, COLS64 = true;
    bf16_t* O; int ldc; const float* ssp; float cscale; unsigned* nrm;
    static constexpr bool HAS_PRE = true;
    __device__ __forceinline__ void pre(const Unit& u, int t, float (&rsv)[16]) const { if (ssp) pre_ssp(ssp, u.orow, t, rsv); }
    __device__ __forceinline__ void operator()(f32x4 (&acc)[2][2][4][2], const Unit& u, int wr, int wc, int fr, int fq, LAS unsigned char* lds, const float (&rsv)[16], int t) const {
        const int row0 = u.orow + wr * 64 + fr, col0 = u.ocol + wc * 64 + 8 * fq;
        if (ssp) xchg_ssp(rsv, t, lds);
        const LAS float* rsl = (const LAS float*)(lds + RSL_OFF) + wr * 64 + fr;
        float cs = 1.f; bool gel = false;
        if (MODE == 0) cs = cscale;
        if (MODE == 1) { gel = u.tag < 4; if (u.tag == 4 || u.tag == 5) cs = cscale; }
        if (MODE == 2) { if (u.tag < 2) cs = cscale; }
        const bool trk = (MODE == 1 && u.tag >= 4 && u.tag < 8) || (MODE == 2 && u.tag < 4); float nmx0 = 0.f, nmx1 = 0.f;
#pragma unroll
        for (int ai = 0; ai < 2; ++ai)
#pragma unroll
            for (int m = 0; m < 4; ++m) {
                const int row = row0 + ai * HALF + m * 16;
                const float rs = (ssp ? rsl[ai * HALF + m * 16] : 1.f) * cs;
                bf16_t* rowp = O + (size_t)row * ldc + col0;
#pragma unroll
                for (int bj = 0; bj < 2; ++bj) {
                    f32x4 v0 = acc[ai][bj][m][0] * rs, v1 = acc[ai][bj][m][1] * rs;
                    if (MODE == 1) { if (gel) {
#pragma unroll
                        for (int e = 0; e < 4; ++e) { v0[e] = gelu_tanh(v0[e]); v1[e] = gelu_tanh(v1[e]); } } }
                    if (MODE == 1 || MODE == 2) { if (trk) { float sq = (v0[0] * v0[0] + v0[1] * v0[1]) + (v0[2] * v0[2] + v0[3] * v0[3]) + (v1[0] * v1[0] + v1[1] * v1[1]) + (v1[2] * v1[2] + v1[3] * v1[3]);
                        sq += __shfl_xor(sq, 16); sq += __shfl_xor(sq, 32); if (bj == 0) nmx0 = fmaxf(nmx0, sq); else nmx1 = fmaxf(nmx1, sq); } }
                    u32x4 w; w.x = cvt_pk_bf16(v0[0], v0[1]); w.y = cvt_pk_bf16(v0[2], v0[3]); w.z = cvt_pk_bf16(v1[0], v1[1]); w.w = cvt_pk_bf16(v1[2], v1[3]);
                    *(u32x4*)(rowp + bj * 32) = w; }
            }
        if (MODE == 1 || MODE == 2) { if (trk) {
#pragma unroll
            for (int o = 1; o < 16; o <<= 1) { nmx0 = fmaxf(nmx0, __shfl_xor(nmx0, o)); nmx1 = fmaxf(nmx1, __shfl_xor(nmx1, o)); }
            if (fr == 0 && fq == 0) { const int b = u.orow >> 13;
                if (MODE == 1) { const int kind = (u.tag - 4) >> 1, hd = 2 * ((u.tag - 4) & 1) + (wc >> 1);
                    unsigned* p = nrm + ((b * 2 + kind) * 4 + hd) * 4 + 2 * (wc & 1);
                    __hip_atomic_fetch_max(p, __float_as_uint(nmx0), __ATOMIC_RELAXED, __HIP_MEMORY_SCOPE_AGENT);
                    __hip_atomic_fetch_max(p + 1, __float_as_uint(nmx1), __ATOMIC_RELAXED, __HIP_MEMORY_SCOPE_AGENT); }
                else { const int kind = u.tag >> 1, br = u.tag & 1;
                    unsigned* p = nrm + ((((b * 2 + kind) * 2 + br) * 4 + wc) * 2);
                    __hip_atomic_fetch_max(p, __float_as_uint(nmx0), __ATOMIC_RELAXED, __HIP_MEMORY_SCOPE_AGENT);
                    __hip_atomic_fetch_max(p + 1, __float_as_uint(nmx1), __ATOMIC_RELAXED, __HIP_MEMORY_SCOPE_AGENT); } } } }
    }
};
struct EpiPart {
    static constexpr bool PERM = true, COLS64 = true;
    float* P;
    __device__ __forceinline__ void operator()(f32x4 (&acc)[2][2][4][2], const Unit& u, int wr, int wc, int fr, int fq, LAS unsigned char*) const {
        float* base = P + (size_t)u.tag * 65536 + (size_t)(wr * 64 + fr) * 256 + wc * 64 + 8 * fq;
#pragma unroll
        for (int ai = 0; ai < 2; ++ai)
#pragma unroll
            for (int m = 0; m < 4; ++m)
#pragma unroll
                for (int bj = 0; bj < 2; ++bj) { float* p = base + (size_t)(ai * HALF + m * 16) * 256 + bj * 32; *(f32x4*)p = acc[ai][bj][m][0]; *(f32x4*)(p + 4) = acc[ai][bj][m][1]; }
    }
};
struct EpiResid {
    static constexpr bool PERM = true, COLS64 = true;
    const float* xin; bf16_t* xb; float* ssp; float sc = 1.0f;
    __device__ __forceinline__ void operator()(f32x4 (&acc)[2][2][4][2], const Unit& u, int wr, int wc, int fr, int fq, LAS unsigned char*) const {
        const int row0 = u.orow + wr * 64 + fr, col0 = u.ocol + wc * 64 + 8 * fq;
#pragma unroll
        for (int ai = 0; ai < 2; ++ai)
#pragma unroll
            for (int m = 0; m < 4; ++m) {
                const int row = row0 + ai * HALF + m * 16; const size_t off = (size_t)row * D + col0; float sq = 0.f;
#pragma unroll
                for (int bj = 0; bj < 2; ++bj) {
                    f32x4 o0, o1;
                    if (xin) { o0 = *(const f32x4*)(xin + off + bj * 32); o1 = *(const f32x4*)(xin + off + bj * 32 + 4); }
                    else { const u32x4 q = *(const u32x4*)(xb + off + bj * 32); o0 = (f32x4){bflo(q.x), bfhi(q.x), bflo(q.y), bfhi(q.y)}; o1 = (f32x4){bflo(q.z), bfhi(q.z), bflo(q.w), bfhi(q.w)}; }
                    o0 = o0 + acc[ai][bj][m][0] * sc; o1 = o1 + acc[ai][bj][m][1] * sc;
                    u32x4 w; w.x = cvt_pk_bf16(o0[0], o0[1]); w.y = cvt_pk_bf16(o0[2], o0[3]); w.z = cvt_pk_bf16(o1[0], o1[1]); w.w = cvt_pk_bf16(o1[2], o1[3]);
                    *(u32x4*)(xb + off + bj * 32) = w;
                    sq += (o0[0] * o0[0] + o0[1] * o0[1]) + (o0[2] * o0[2] + o0[3] * o0[3]) + (o1[0] * o1[0] + o1[1] * o1[1]) + (o1[2] * o1[2] + o1[3] * o1[3]); }
                sq += __shfl_xor(sq, 16); sq += __shfl_xor(sq, 32);
                if (fq == 0) ssp[(size_t)row * 16 + u.tag * 4 + wc] = sq;
                if (m & 1) asm volatile("" ::: "memory");
            }
    }
};
template <bool OUT8> struct EpiSwiGLU {
    static constexpr bool PERM = true, COLS64 = false;
    bf16_t* O; int ldc; const float* ssp; const float* rsd;
    static constexpr bool HAS_PRE = true;
    __device__ __forceinline__ void pre(const Unit& u, int t, float (&rsv)[16]) const {
        if (ssp) { pre_ssp(ssp, u.orow, t, rsv); return; }
        const int wr = t >> 8, fr = t & 15; const int row0 = u.orow + wr * 64 + fr;
#pragma unroll
        for (int ai = 0; ai < 2; ++ai)
#pragma unroll
            for (int m = 0; m < 4; ++m) rsv[ai * 4 + m] = rsd[row0 + ai * HALF + m * 16];
    }
    __device__ __forceinline__ void operator()(f32x4 (&acc)[2][2][4][2], const Unit& u, int wr, int wc, int fr, int fq, LAS unsigned char* lds, const float (&rsv)[16], int t) const {
        const int row0 = u.orow + wr * 64 + fr, col0 = u.ocol + wc * 32 + 8 * fq;
        if (ssp) xchg_ssp(rsv, t, lds);
        const LAS float* rsl = (const LAS float*)(lds + RSL_OFF) + wr * 64 + fr;
#pragma unroll
        for (int ai = 0; ai < 2; ++ai)
#pragma unroll
            for (int m = 0; m < 4; ++m) {
                const int row = row0 + ai * HALF + m * 16;
                const float rs = ssp ? rsl[ai * HALF + m * 16] : rsv[ai * 4 + m]; const float c1 = -LOG2E * rs, c2 = rs * rs;
                f32x4 h0, h1;
                const f32x2 c1v = (f32x2){c1, c1}, c2v = (f32x2){c2, c2};
#pragma unroll
                for (int e = 0; e < 4; e += 2) {
#pragma unroll
                    for (int n = 0; n < 2; ++n) {
                        const f32x2 gg = (f32x2){acc[ai][0][m][n][e], acc[ai][0][m][n][e + 1]}, uu = (f32x2){acc[ai][1][m][n][e], acc[ai][1][m][n][e + 1]};
                        const f32x2 tt = gg * c1v; const f32x2 dd = (f32x2){fast_exp2(tt.x), fast_exp2(tt.y)} + (f32x2){1.0f, 1.0f};
                        const f32x2 hh = ((gg * uu) * c2v) * (f32x2){fast_rcp(dd.x), fast_rcp(dd.y)};
                        if (n == 0) { h0[e] = hh.x; h0[e + 1] = hh.y; } else { h1[e] = hh.x; h1[e + 1] = hh.y; } } }
                if constexpr (OUT8) { u32x2 w; w.x = pk4_fp8(h0[0], h0[1], h0[2], h0[3]); w.y = pk4_fp8(h1[0], h1[1], h1[2], h1[3]);
                    *(u32x2*)((unsigned char*)O + (size_t)u.orow * ldc + (size_t)(u.ocol >> 7) * 32768 + (row - u.orow) * 128 + (col0 - u.ocol)) = w; }
                else { u32x4 w; w.x = cvt_pk_bf16(h0[0], h0[1]); w.y = cvt_pk_bf16(h0[2], h0[3]); w.z = cvt_pk_bf16(h1[0], h1[1]); w.w = cvt_pk_bf16(h1[2], h1[3]);
                    *(u32x4*)(O + (size_t)row * ldc + col0) = w; }
            }
    }
};
struct EpiSoftmax {
    static constexpr bool PERM = true, COLS64 = true;
    bf16_t* O; int ldc; const float* ssp;
    static constexpr bool HAS_PRE = true;
    __device__ __forceinline__ void pre(const Unit& u, int t, float (&rsv)[16]) const { pre_ssp(ssp, u.orow, t, rsv); }
    __device__ __forceinline__ void operator()(f32x4 (&acc)[2][2][4][2], const Unit& u, int wr, int wc, int fr, int fq, LAS unsigned char* lds, const float (&rsv)[16], int t) const {
        LAS float* red1 = (LAS float*)(lds + EPI_OFF); LAS float* red2 = red1 + 1024;
        const int row0 = u.orow + wr * 64 + fr, col0 = u.ocol + wc * 64 + 8 * fq;
        xchg_ssp(rsv, t, lds);
        const LAS float* rsl = (const LAS float*)(lds + RSL_OFF) + wr * 64 + fr;
#pragma unroll
        for (int ai = 0; ai < 2; ++ai)
#pragma unroll
            for (int m = 0; m < 4; ++m) {
                const float rs = rsl[ai * HALF + m * 16]; float mx = -3.0e38f;
#pragma unroll
                for (int bj = 0; bj < 2; ++bj)
#pragma unroll
                    for (int n = 0; n < 2; ++n) { f32x4 v = acc[ai][bj][m][n] * rs; acc[ai][bj][m][n] = v; mx = fmaxf(mx, fmaxf(fmaxf(v[0], v[1]), fmaxf(v[2], v[3]))); }
                mx = fmaxf(mx, __shfl_xor(mx, 16)); mx = fmaxf(mx, __shfl_xor(mx, 32));
                if (fq == 0) red1[(ai * HALF + wr * 64 + m * 16 + fr) * 4 + wc] = mx;
            }
        asm volatile("s_waitcnt lgkmcnt(0)" ::: "memory"); __builtin_amdgcn_s_barrier(); asm volatile("" ::: "memory");
#pragma unroll
        for (int ai = 0; ai < 2; ++ai)
#pragma unroll
            for (int m = 0; m < 4; ++m) {
                const int tr = ai * HALF + wr * 64 + m * 16 + fr; const f32x4 q = *(LAS f32x4*)(red1 + tr * 4);
                const float mx = fmaxf(fmaxf(q[0], q[1]), fmaxf(q[2], q[3])); float s = 0.f;
#pragma unroll
                for (int bj = 0; bj < 2; ++bj)
#pragma unroll
                    for (int n = 0; n < 2; ++n) { f32x4 v = acc[ai][bj][m][n];
#pragma unroll
                        for (int e = 0; e < 4; ++e) { v[e] = fast_exp2(v[e] - mx); s += v[e]; }
                        acc[ai][bj][m][n] = v; }
                s += __shfl_xor(s, 16); s += __shfl_xor(s, 32);
                if (fq == 0) red2[tr * 4 + wc] = s;
            }
        asm volatile("s_waitcnt lgkmcnt(0)" ::: "memory"); __builtin_amdgcn_s_barrier(); asm volatile("" ::: "memory");
#pragma unroll
        for (int ai = 0; ai < 2; ++ai)
#pragma unroll
            for (int m = 0; m < 4; ++m) {
                const int tr = ai * HALF + wr * 64 + m * 16 + fr; const f32x4 q = *(LAS f32x4*)(red2 + tr * 4);
                const float inv = 1.0f / ((q[0] + q[1]) + (q[2] + q[3]));
                bf16_t* rowp = O + (size_t)(row0 + ai * HALF + m * 16) * ldc + col0;
#pragma unroll
                for (int bj = 0; bj < 2; ++bj) { const f32x4 v0 = acc[ai][bj][m][0] * inv, v1 = acc[ai][bj][m][1] * inv;
                    u32x4 w; w.x = cvt_pk_bf16(v0[0], v0[1]); w.y = cvt_pk_bf16(v0[2], v0[3]); w.z = cvt_pk_bf16(v1[0], v1[1]); w.w = cvt_pk_bf16(v1[2], v1[3]);
                    *(u32x4*)(rowp + bj * 32) = w; }
            }
    }
};

template <class T, class = void> struct has_pre { static constexpr bool value = false; };
template <class T> struct has_pre<T, decltype((void)T::HAS_PRE)> { static constexpr bool value = true; };
template <class Epi, class Sched, bool ALIGN_EPI, bool FP8 = false>
__device__ __forceinline__ void gemm_phase(LAS unsigned char* lds, const Gemm g, const Sched& S, const Epi& E) {
    int tid_ = threadIdx.x; asm volatile("" : "+v"(tid_));
    const int tid = tid_, wid = __builtin_amdgcn_readfirstlane(tid >> 6), lane = tid & 63, wr = wid >> 2, wc = wid & 3, fr = lane & 15, fq = lane >> 4;
    const int K = g.K, nt = K / BK;
    unsigned voffA[2], voffB[2];
#pragma unroll
    for (int i = 0; i < 2; ++i) { int R, C; stage_rc(tid * 16 + i * 8192, R, C); const int Rb = Epi::COLS64 ? (64 * (R >> 5) + perm32(R & 31)) : ((R & ~31) + perm32(R & 31));
        voffA[i] = (unsigned)(R * g.lda + C) * 2u; voffB[i] = (unsigned)(Rb * g.ldb + C) * 2u; }
    const size_t kstep = (size_t)(BK * 2), kstepA = g.ksA ? (size_t)g.ksA : kstep;
    const size_t hstepA = (size_t)HALF * g.lda * 2, hstepB = (size_t)(Epi::COLS64 ? 32 : HALF) * g.ldb * 2;
    const unsigned ldsw = (unsigned)wid * 1024u;
    const int aoff = lds_byte(wr * 64 + fr, fq * 8), boff = lds_byte(wc * 32 + fr, fq * 8);
#define PG8_SA(b, h) (((b) * 2 + (h)) * HTB)
#define PG8_SB(b, h) ((4 + (b) * 2 + (h)) * HTB)
#define PG8_STAGE(bufoff, gbase, voff) do { _Pragma("unroll") for (int _i = 0; _i < 2; ++_i) \
        __builtin_amdgcn_global_load_lds((const unsigned*)((const char*)(gbase) + (voff)[_i]), (LAS unsigned*)(lds + (bufoff) + ldsw + _i * 8192), 16, 0, 0); } while (0)
#define PG8_LDA(dst, b, h) do { _Pragma("unroll") for (int m = 0; m < 4; ++m) { if constexpr (FP8) { const u32x4 lo_ = *(const LAS u32x4*)(lds + PG8_SA(b, h) + aoff + m * 2048), hi_ = *(const LAS u32x4*)(lds + PG8_SA(b, h) + aoff + m * 2048 + 1024); \
            dst##8[m] = (v8i_t){(int)lo_.x, (int)lo_.y, (int)lo_.z, (int)lo_.w, (int)hi_.x, (int)hi_.y, (int)hi_.z, (int)hi_.w}; } \
        else { _Pragma("unroll") for (int k = 0; k < 2; ++k) dst[m][k] = *(const LAS bf16x8*)(lds + PG8_SA(b, h) + aoff + m * 2048 + k * 1024); } } } while (0)
#define PG8_LDB(dst, b, h) do { _Pragma("unroll") for (int n = 0; n < 2; ++n) { if constexpr (FP8) { const u32x4 lo_ = *(const LAS u32x4*)(lds + PG8_SB(b, h) + boff + n * 2048), hi_ = *(const LAS u32x4*)(lds + PG8_SB(b, h) + boff + n * 2048 + 1024); \
            dst##8[n] = (v8i_t){(int)lo_.x, (int)lo_.y, (int)lo_.z, (int)lo_.w, (int)hi_.x, (int)hi_.y, (int)hi_.z, (int)hi_.w}; } \
        else { _Pragma("unroll") for (int k = 0; k < 2; ++k) dst[n][k] = *(const LAS bf16x8*)(lds + PG8_SB(b, h) + boff + n * 2048 + k * 1024); } } } while (0)
#define PG8_MMA(ai, bj, At, Bt) do { __builtin_amdgcn_s_setprio(1); \
        if constexpr (FP8) { _Pragma("unroll") for (int m = 0; m < 4; ++m) _Pragma("unroll") for (int n = 0; n < 2; ++n) \
            asm volatile("v_mfma_f32_16x16x128_f8f6f4 %0, %1, %2, %0" : "+v"(acc[ai][bj][m][n]) : "v"(Bt##8[n]), "v"(At##8[m])); }   \
        else { _Pragma("unroll") for (int m = 0; m < 4; ++m) _Pragma("unroll") for (int n = 0; n < 2; ++n) _Pragma("unroll") for (int k = 0; k < 2; ++k) \
            acc[ai][bj][m][n] = __builtin_amdgcn_mfma_f32_16x16x32_bf16(Bt[n][k], At[m][k], acc[ai][bj][m][n], 0, 0, 0); } \
        __builtin_amdgcn_s_setprio(0); } while (0)
#define PG8_WAIT_V(n) asm volatile("s_waitcnt vmcnt(" #n ")" ::: "memory")
#define PG8_WAIT_L(n) asm volatile("s_waitcnt lgkmcnt(" #n ")" ::: "memory")
#define PG8_BAR __builtin_amdgcn_s_barrier()
#define PG8_SCHED __builtin_amdgcn_sched_barrier(0)
    Unit cur, nxt; int ui = 0;
    if (!S.next(0, cur)) return;
    f32x4 acc[2][2][4][2];
#pragma unroll
    for (int a = 0; a < 2; ++a)
#pragma unroll
        for (int b = 0; b < 2; ++b)
#pragma unroll
            for (int m = 0; m < 4; ++m)
#pragma unroll
                for (int n = 0; n < 2; ++n) acc[a][b][m][n] = (f32x4){0.f, 0.f, 0.f, 0.f};

#define PG8_PIN_ACC() do { if constexpr (FP8) { _Pragma("unroll") for (int a_ = 0; a_ < 2; ++a_) _Pragma("unroll") for (int b_ = 0; b_ < 2; ++b_) \
        asm volatile("" : "+v"(acc[a_][b_][0][0]), "+v"(acc[a_][b_][0][1]), "+v"(acc[a_][b_][1][0]), "+v"(acc[a_][b_][1][1]), "+v"(acc[a_][b_][2][0]), "+v"(acc[a_][b_][2][1]), "+v"(acc[a_][b_][3][0]), "+v"(acc[a_][b_][3][1])); } } while (0)
    PG8_PIN_ACC();
    bf16x8 At[4][2], B0[2][2], B1[2][2]; v8i_t At8[4], B08[2], B18[2]; (void)At; (void)B0; (void)B1; (void)At8; (void)B08; (void)B18;
    const char* cA = cur.a; const char* cB = cur.b;
    float rsv[16] = {0.f, 0.f, 0.f, 0.f, 0.f, 0.f, 0.f, 0.f, 0.f, 0.f, 0.f, 0.f, 0.f, 0.f, 0.f, 0.f}; (void)rsv;
    if constexpr (has_pre<Epi>::value) E.pre(cur, tid, rsv);
    PG8_STAGE(PG8_SB(0, 0), cB, voffB); PG8_STAGE(PG8_SB(0, 1), cB + hstepB, voffB); PG8_STAGE(PG8_SA(0, 0), cA, voffA); PG8_STAGE(PG8_SA(0, 1), cA + hstepA, voffA);
    if (wr == 1) PG8_BAR;
    PG8_WAIT_V(2); PG8_BAR;
    PG8_STAGE(PG8_SB(1, 0), cB + kstep, voffB); PG8_STAGE(PG8_SA(1, 0), cA + kstepA, voffA); PG8_STAGE(PG8_SB(1, 1), cB + hstepB + kstep, voffB);
    PG8_WAIT_V(6); PG8_BAR;
    for (;;) {
        const bool has_next = S.next(ui + 1, nxt);
        const char* nA = has_next ? nxt.a : cA; const char* nB = has_next ? nxt.b : cB;
        for (int t = 0; t < nt; t += 2) {
            const bool last = (t == nt - 2);
            const char* a1 = cA + (size_t)(t + 1) * kstepA;
            const char* a2 = last ? nA : cA + (size_t)(t + 2) * kstepA; const char* b2 = last ? nB : cB + (size_t)(t + 2) * kstep;
            const char* a3 = a2 + kstepA; const char* b3 = b2 + kstep;
            PG8_LDB(B0, 0, 0); PG8_LDB(B1, 0, 1); PG8_SCHED; PG8_LDA(At, 0, 0); PG8_STAGE(PG8_SA(1, 1), a1 + hstepA, voffA);
            PG8_WAIT_V(8); PG8_WAIT_L(0); PG8_BAR; PG8_MMA(0, 0, At, B0); PG8_MMA(0, 1, At, B1); PG8_BAR; PG8_SCHED;
            PG8_LDA(At, 0, 1); PG8_STAGE(PG8_SB(0, 0), b2, voffB); PG8_STAGE(PG8_SB(0, 1), b2 + hstepB, voffB); PG8_STAGE(PG8_SA(0, 0), a2, voffA);
            PG8_WAIT_V(8); PG8_WAIT_L(0); PG8_BAR; PG8_MMA(1, 0, At, B0); PG8_MMA(1, 1, At, B1); PG8_BAR; PG8_SCHED;
            PG8_LDB(B0, 1, 0); PG8_LDB(B1, 1, 1); PG8_SCHED; PG8_LDA(At, 1, 0); PG8_STAGE(PG8_SA(0, 1), a2 + hstepA, voffA);
            PG8_WAIT_V(8); PG8_WAIT_L(0); PG8_BAR; PG8_MMA(0, 0, At, B0); PG8_MMA(0, 1, At, B1); PG8_BAR; PG8_SCHED;
            PG8_LDA(At, 1, 1); PG8_STAGE(PG8_SB(1, 0), b3, voffB); PG8_STAGE(PG8_SB(1, 1), b3 + hstepB, voffB); PG8_STAGE(PG8_SA(1, 0), a3, voffA);
            PG8_WAIT_V(8); PG8_WAIT_L(0); PG8_BAR; PG8_MMA(1, 0, At, B0); PG8_MMA(1, 1, At, B1); PG8_BAR; PG8_SCHED;
        }
        if constexpr (FP8) asm volatile("s_nop 15\n\ts_nop 15" ::: "memory");
        if constexpr (ALIGN_EPI) { if (wr == 0) PG8_BAR; }
        {
            int t2 = threadIdx.x; asm volatile("" : "+v"(t2));
            const int wid2 = __builtin_amdgcn_readfirstlane(t2 >> 6), lane2 = t2 & 63;
            if constexpr (has_pre<Epi>::value) E(acc, cur, wid2 >> 2, wid2 & 3, lane2 & 15, lane2 >> 4, lds, rsv, t2);
            else E(acc, cur, wid2 >> 2, wid2 & 3, lane2 & 15, lane2 >> 4, lds);
        }
        if (!has_next) break;
#pragma unroll
        for (int a = 0; a < 2; ++a)
#pragma unroll
            for (int b = 0; b < 2; ++b)
#pragma unroll
                for (int m = 0; m < 4; ++m)
#pragma unroll
                    for (int n = 0; n < 2; ++n) acc[a][b][m][n] = (f32x4){0.f, 0.f, 0.f, 0.f};
        PG8_PIN_ACC();
        cur = nxt; cA = nA; cB = nB; ++ui;
        if constexpr (has_pre<Epi>::value) { int t3 = threadIdx.x; asm volatile("" : "+v"(t3)); E.pre(cur, t3, rsv); }
        if constexpr (ALIGN_EPI) { if (wr == 1) PG8_BAR; }
    }
    PG8_WAIT_V(0);
    if constexpr (!ALIGN_EPI) { if (wr == 0) PG8_BAR; }
    PG8_BAR;
#undef PG8_SA
#undef PG8_SB
#undef PG8_STAGE
#undef PG8_LDA
#undef PG8_LDB
#undef PG8_MMA
#undef PG8_WAIT_V
#undef PG8_WAIT_L
#undef PG8_BAR
#undef PG8_SCHED
#undef PG8_PIN_ACC
}
}

struct Job { const float* src; const float* gain; bf16_t* dst; int ld, Kd, nnb, mode, start, pad; };
constexpr int NJOBS = 4 + 2 + 2 + 3 + 24;
__device__ __forceinline__ void tr_load(f32x4 (&v)[16], const float* W, int ld, int k0, int n0, int lane) {
    const int lr = lane >> 4, lc = (lane & 15) * 4;
#pragma unroll
    for (int i = 0; i < 16; ++i) v[i] = *(const GAS f32x4*)(W + (size_t)(k0 + 4 * i + lr) * ld + n0 + lc);
}
__device__ __forceinline__ void tr_emit(f32x4 (&v)[16], int k0, const float* gain, bf16_t* dst, int Kd, int drow0, LAS float* scr, int lane, bool f8) {
    const int lr = lane >> 4, lc = (lane & 15) * 4;
    if (gain) {
#pragma unroll
        for (int i = 0; i < 16; ++i) v[i] = v[i] * ((const GAS float*)gain)[k0 + 4 * i + lr];
    }
#pragma unroll
    for (int i = 0; i < 16; ++i) { LAS float* s = scr + (4 * i + lr) * 65 + lc; s[0] = v[i][0]; s[1] = v[i][1]; s[2] = v[i][2]; s[3] = v[i][3]; }
    LDS_WAIT(); asm volatile("" ::: "memory");
    const int c = lane >> 3, nl = lane & 7;
    if (f8) {
#pragma unroll
        for (int j = 0; j < 8; ++j) { const int n = nl + 8 * j; const LAS float* s = scr + (8 * c) * 65 + n;
            u32x2 o; o.x = pk4_fp8(s[0 * 65] * 64.f, s[1 * 65] * 64.f, s[2 * 65] * 64.f, s[3 * 65] * 64.f); o.y = pk4_fp8(s[4 * 65] * 64.f, s[5 * 65] * 64.f, s[6 * 65] * 64.f, s[7 * 65] * 64.f);
            *(GAS u32x2*)((unsigned char*)dst + (size_t)(drow0 + n) * Kd + k0 + 8 * c) = o; }
    } else {
#pragma unroll
    for (int j = 0; j < 8; ++j) { const int n = nl + 8 * j; const LAS float* s = scr + (8 * c) * 65 + n;
        u32x4 o; o.x = cvt_pk_bf16(s[0 * 65], s[1 * 65]); o.y = cvt_pk_bf16(s[2 * 65], s[3 * 65]); o.z = cvt_pk_bf16(s[4 * 65], s[5 * 65]); o.w = cvt_pk_bf16(s[6 * 65], s[7 * 65]);
        *(GAS u32x4*)(dst + (size_t)(drow0 + n) * Kd + k0 + 8 * c) = o; }
    }
    LDS_WAIT(); asm volatile("" ::: "memory");
}
__device__ __forceinline__ void tr_item(const float* W, int ld, int k0, int n0, const float* gain, bf16_t* dst, int Kd, int drow0, LAS float* scr, int lane, bool f8) {
    f32x4 v[16]; tr_load(v, W, ld, k0, n0, lane); tr_emit(v, k0, gain, dst, Kd, drow0, scr, lane, f8);
}

constexpr int MOE_ITEMS_GU = 8 * 2 * 16 * 56, MOE_ITEMS = MOE_ITEMS_GU + 8 * 56 * 16;
#ifndef FFN_D8
#define FFN_D8 1
#endif
#ifndef MK_Q1
#define MK_Q1 4
#endif
#ifndef MK_Q6
#define MK_Q6 4
#endif
#ifndef MK_QS
#define MK_QS 1
#endif
#ifndef MK_Q9
#define MK_Q9 4
#endif
__device__ __forceinline__ void moe_convert(gu32* ctr, int maxpulls, const float* wg, const float* wu, const float* wd, const float* gain, unsigned char* wgue, unsigned char* wde, LAS unsigned char* lds) {
    int t_ = threadIdx.x; asm volatile("" : "+v"(t_));
    const int wave = __builtin_amdgcn_readfirstlane(t_ >> 6), lane = t_ & 63;
    LAS float* scr = (LAS float*)(lds + wave * 16640); LAS int* sel = (LAS int*)(lds + 140 * 1024 + 64);
    constexpr int ES = MOE_FP8 ? 1 : 2;
    for (int p = 0; p < maxpulls; ++p) {
        __syncthreads();
        if (t_ == 0) sel[0] = (int)__hip_atomic_fetch_add(ctr, 8u, RLX_AGENT);
        __syncthreads();
        const int base = sel[0]; if (base >= MOE_ITEMS) break;
        const int it = base + wave;
        if (it < MOE_ITEMS_GU) { const int e = it / 1792, r = it % 1792, up = r / 896, local = r % 896, kb = local % 16, nb = local / 16, n0 = nb * 64;
            tr_item((up ? wu : wg) + (size_t)e * D * FFE, FFE, kb * 64, n0, gain, (bf16_t*)(wgue + (size_t)e * 2 * FFE * D * ES), D, 256 * (n0 >> 7) + (up ? 128 : 0) + (n0 & 127), scr, lane, MOE_FP8); }
        else if (it < MOE_ITEMS) { const int i2 = it - MOE_ITEMS_GU, e = i2 / 896, local = i2 % 896, kb = local % 56, nb = local / 56;
            tr_item(wd + (size_t)e * FFE * D, D, kb * 64, nb * 64, nullptr, (bf16_t*)(wde + (size_t)e * D * FFE * ES), FFE, nb * 64, scr, lane, MOE_FP8); }
    }
    __syncthreads();
}
#define MOE_CONVERT(n) moe_convert((gu32*)(ws + WS_CTL) + CW_MOEQ, (n), moe_w_gate, moe_w_up, moe_w_down, norm_ffn + D, (unsigned char*)WGUE, (unsigned char*)WDE, lds)

__device__ __forceinline__ int rel_bucket(int rel) {
    const int ret = rel > 0 ? 16 : 0; const int n = rel < 0 ? -rel : rel;
    if (n < 8) return ret + n;
    int large = 8 + (int)(logf((float)n / 8.0f) / 2.772588722239781f * 8.0f + 1e-4f);
    large = large < 15 ? large : 15;
    return ret + large;
}

namespace att {
typedef short s16x4 __attribute__((ext_vector_type(4)));
typedef float f32x16 __attribute__((ext_vector_type(16)));
typedef LAS unsigned char* lptr;
#define KSWZ(row, colB) ((row) * 256 + ((colB) ^ (((row) & 7) << 4)))
#define SBAR() __builtin_amdgcn_sched_barrier(0)
constexpr int SHM_T = 16384;
__device__ __forceinline__ int v_st(int k, int c) { const int kk = (k & ~0xC) | ((k & 4) << 1) | ((k & 8) >> 1); return ((kk >> 3) * 4 + (c >> 5)) * 512 + ((kk & 7) * 32 + (c & 31)) * 2; }
__device__ __forceinline__ int v_rd_base(int lane) { return ((lane & 3) << 3) | (((lane >> 2) & 3) << 6) | (((lane >> 4) & 1) << 5) | (((lane >> 5) & 1) << 8); }
constexpr int v_rd_off(int d0, int ks, int half) { return d0 * 512 + ks * 4096 + half * 2048; }
__device__ __forceinline__ int crow(int r, int hi) { return (r & 3) + 8 * (r >> 2) + 4 * hi; }
constexpr float THRL = 8.0f;
__device__ __forceinline__ bf16x8 kone_frag(int hi) { bf16x8 k = {0, 0, 0, 0, 0, 0, 0, 0}; k[0] = hi == 0 ? (short)0x3F80 : (short)0; return k; }
template <bool FIRST>
__device__ __forceinline__ void partialSM(f32x16& p0, f32x16& p1, float& mhat, float& l_reg, float& alpha, bf16x8& qx, int hi) {
    float a = fmaxf(fmaxf(p0[0], p0[1]), p0[2]), b = fmaxf(fmaxf(p1[0], p1[1]), p1[2]);
#pragma unroll
    for (int r = 3; r < 15; r += 2) { a = fmaxf(fmaxf(a, p0[r]), p0[r + 1]); b = fmaxf(fmaxf(b, p1[r]), p1[r + 1]); }
    float pmax = fmaxf(fmaxf(a, b), fmaxf(p0[15], p1[15]));
    { auto rr = __builtin_amdgcn_permlane32_swap(__float_as_uint(pmax), __float_as_uint(pmax), false, false); pmax = fmaxf(__uint_as_float(rr[0]), __uint_as_float(rr[1])); }
    alpha = 1.f;
    if (FIRST || __builtin_expect(__any(pmax > THRL), 0)) {
        const float d = FIRST ? (pmax > -1e30f ? pmax : 0.f) : fmaxf(pmax, 0.f);
        const unsigned mb = cvt_pk_bf16(mhat + d, 0.f) & 0xffffu; const float mn = __uint_as_float(mb << 16), delta = mn - mhat; mhat = mn;
#pragma unroll
        for (int r = 0; r < 16; ++r) { p0[r] -= delta; p1[r] -= delta; }
        if (!FIRST) { alpha = fast_exp2(-delta); l_reg *= alpha; }
        qx[0] = hi == 0 ? (short)(mb ^ 0x8000u) : (short)0;
    }
#pragma unroll
    for (int r = 0; r < 16; ++r) p0[r] = fast_exp2(p0[r]);
}
__device__ __forceinline__ void finishSM(f32x16& p0, f32x16& p1, float& l_reg, bf16x8& pa0, bf16x8& pa1, bf16x8& pa2, bf16x8& pa3) {
#pragma unroll
    for (int r = 0; r < 16; ++r) p1[r] = fast_exp2(p1[r]);
#define PR2(P, r) ((f32x2){P[r], P[(r) + 1]})
    f32x2 c0 = PR2(p0, 0) + PR2(p0, 2), c1 = PR2(p0, 4) + PR2(p0, 6), c2 = PR2(p0, 8) + PR2(p0, 10), c3 = PR2(p0, 12) + PR2(p0, 14);
    c0 += PR2(p1, 0); c1 += PR2(p1, 2); c2 += PR2(p1, 4); c3 += PR2(p1, 6); c0 += PR2(p1, 8); c1 += PR2(p1, 10); c2 += PR2(p1, 12); c3 += PR2(p1, 14);
#undef PR2
    const f32x2 cs = (c0 + c1) + (c2 + c3);
    float ps = cs.x + cs.y;
    { auto rr = __builtin_amdgcn_permlane32_swap(__float_as_uint(ps), __float_as_uint(ps), false, false); ps = __uint_as_float(rr[0]) + __uint_as_float(rr[1]); }
    l_reg += ps;
#define PK8(P, B_, OUT) do { u32x4 w = {cvt_pk_bf16(P[B_+0], P[B_+1]), cvt_pk_bf16(P[B_+2], P[B_+3]), cvt_pk_bf16(P[B_+4], P[B_+5]), cvt_pk_bf16(P[B_+6], P[B_+7])}; OUT = *reinterpret_cast<bf16x8*>(&w); } while (0)
    PK8(p0, 0, pa0); PK8(p0, 8, pa1); PK8(p1, 0, pa2); PK8(p1, 8, pa3);
#undef PK8
}
template <bool MASK>
__device__ __forceinline__ void fox_init(f32x16& p0, f32x16& p1, const LAS float* nb, int hi, int dq) {
    const LAS f32x4* nb_ = (const LAS f32x4*)(nb + 4 * hi); const float NEG = -__builtin_inff();
#pragma unroll
    for (int g = 0; g < 4; ++g) { const f32x4 b0 = nb_[2 * g], b1 = nb_[8 + 2 * g];
#pragma unroll
        for (int e = 0; e < 4; ++e) { const int c = e + 8 * g;
            p0[4 * g + e] = (MASK && dq - c < 0) ? NEG : b0[e]; p1[4 * g + e] = (MASK && dq - c - 32 < 0) ? NEG : b1[e]; } }
}
__device__ __forceinline__ void qkt128(f32x16& p0, f32x16& p1, lptr Kt, int r32, int hi, const bf16x8* qr, bf16x8 kone, bf16x8 qx) {
    lptr kb[4];
#pragma unroll
    for (int dd = 0; dd < 4; ++dd) kb[dd] = Kt + KSWZ(r32, (dd * 16 + hi * 8) * 2);
#pragma unroll
    for (int d0 = 0; d0 < 8; ++d0) { lptr a = kb[d0 & 3] + (d0 >> 2) * 128;
        const bf16x8 b0 = *(const LAS bf16x8*)(a); const bf16x8 b1 = *(const LAS bf16x8*)(a + 32 * 256);
        p0 = __builtin_amdgcn_mfma_f32_32x32x16_bf16(b0, qr[d0], p0, 0, 0, 0);
        p1 = __builtin_amdgcn_mfma_f32_32x32x16_bf16(b1, qr[d0], p1, 0, 0, 0); }
    p0 = __builtin_amdgcn_mfma_f32_32x32x16_bf16(kone, qx, p0, 0, 0, 0);
    p1 = __builtin_amdgcn_mfma_f32_32x32x16_bf16(kone, qx, p1, 0, 0, 0);
}
template <int VOFF>
__device__ __forceinline__ void pv_tile(f32x16* o, int vb, bf16x8 pa0, bf16x8 pa1, bf16x8 pa2, bf16x8 pa3) {
#define TRRD(dst, off) asm volatile("ds_read_b64_tr_b16 %0, %1 offset:%2" : "=&v"(dst) : "v"(vb), "i"(off) : "memory")
#define PV_D0(d0) do { s16x4 l0, l1, l2, l3, h0, h1, h2, h3; constexpr int b_ = VOFF + v_rd_off(d0, 0, 0); \
        TRRD(l0, b_); TRRD(h0, b_ + 2048); TRRD(l1, b_ + 4096); TRRD(h1, b_ + 6144); TRRD(l2, b_ + 8192); TRRD(h2, b_ + 10240); TRRD(l3, b_ + 12288); TRRD(h3, b_ + 14336); \
        asm volatile("s_waitcnt lgkmcnt(0)" ::: "memory"); SBAR(); \
        o[d0] = __builtin_amdgcn_mfma_f32_32x32x16_bf16(pa0, (bf16x8){l0[0], l0[1], l0[2], l0[3], h0[0], h0[1], h0[2], h0[3]}, o[d0], 0, 0, 0); \
        o[d0] = __builtin_amdgcn_mfma_f32_32x32x16_bf16(pa1, (bf16x8){l1[0], l1[1], l1[2], l1[3], h1[0], h1[1], h1[2], h1[3]}, o[d0], 0, 0, 0); \
        o[d0] = __builtin_amdgcn_mfma_f32_32x32x16_bf16(pa2, (bf16x8){l2[0], l2[1], l2[2], l2[3], h2[0], h2[1], h2[2], h2[3]}, o[d0], 0, 0, 0); \
        o[d0] = __builtin_amdgcn_mfma_f32_32x32x16_bf16(pa3, (bf16x8){l3[0], l3[1], l3[2], l3[3], h3[0], h3[1], h3[2], h3[3]}, o[d0], 0, 0, 0); } while (0)
    PV_D0(0); PV_D0(1); PV_D0(2); PV_D0(3);
#undef PV_D0
#undef TRRD
}

template <int VOFF>
__device__ __forceinline__ void pv_sm(f32x16* o, int vb, bf16x8 pa0, bf16x8 pa1, bf16x8 pa2, bf16x8 pa3, f32x16& p0, f32x16& p1, float& mhat, float& l_reg, float& alpha, bf16x8& qx, int hi) {
#define TRRD(dst, off) asm volatile("ds_read_b64_tr_b16 %0, %1 offset:%2" : "=&v"(dst) : "v"(vb), "i"(off) : "memory")
#define PV_D0(d0) do { s16x4 l0, l1, l2, l3, h0, h1, h2, h3; constexpr int b_ = VOFF + v_rd_off(d0, 0, 0); \
        TRRD(l0, b_); TRRD(h0, b_ + 2048); TRRD(l1, b_ + 4096); TRRD(h1, b_ + 6144); TRRD(l2, b_ + 8192); TRRD(h2, b_ + 10240); TRRD(l3, b_ + 12288); TRRD(h3, b_ + 14336); \
        asm volatile("s_waitcnt lgkmcnt(0)" ::: "memory"); SBAR(); \
        o[d0] = __builtin_amdgcn_mfma_f32_32x32x16_bf16(pa0, (bf16x8){l0[0], l0[1], l0[2], l0[3], h0[0], h0[1], h0[2], h0[3]}, o[d0], 0, 0, 0); \
        o[d0] = __builtin_amdgcn_mfma_f32_32x32x16_bf16(pa1, (bf16x8){l1[0], l1[1], l1[2], l1[3], h1[0], h1[1], h1[2], h1[3]}, o[d0], 0, 0, 0); \
        o[d0] = __builtin_amdgcn_mfma_f32_32x32x16_bf16(pa2, (bf16x8){l2[0], l2[1], l2[2], l2[3], h2[0], h2[1], h2[2], h2[3]}, o[d0], 0, 0, 0); \
        o[d0] = __builtin_amdgcn_mfma_f32_32x32x16_bf16(pa3, (bf16x8){l3[0], l3[1], l3[2], l3[3], h3[0], h3[1], h3[2], h3[3]}, o[d0], 0, 0, 0); } while (0)
    PV_D0(0);
    float a = fmaxf(fmaxf(p0[0], p0[1]), p0[2]);
#pragma unroll
    for (int r = 3; r < 15; r += 2) a = fmaxf(fmaxf(a, p0[r]), p0[r + 1]);
    PV_D0(1);
    float b = fmaxf(fmaxf(p1[0], p1[1]), p1[2]);
#pragma unroll
    for (int r = 3; r < 15; r += 2) b = fmaxf(fmaxf(b, p1[r]), p1[r + 1]);
    float pmax = fmaxf(fmaxf(a, b), fmaxf(p0[15], p1[15]));
    { auto rr = __builtin_amdgcn_permlane32_swap(__float_as_uint(pmax), __float_as_uint(pmax), false, false); pmax = fmaxf(__uint_as_float(rr[0]), __uint_as_float(rr[1])); }
    alpha = 1.f;
    if (__builtin_expect(__any(pmax > THRL), 0)) {
        const float d = fmaxf(pmax, 0.f);
        const unsigned mb = cvt_pk_bf16(mhat + d, 0.f) & 0xffffu; const float mn = __uint_as_float(mb << 16), delta = mn - mhat; mhat = mn;
#pragma unroll
        for (int r = 0; r < 16; ++r) { p0[r] -= delta; p1[r] -= delta; }
        alpha = fast_exp2(-delta); l_reg *= alpha;
        qx[0] = hi == 0 ? (short)(mb ^ 0x8000u) : (short)0;
    }
    PV_D0(2);
#pragma unroll
    for (int r = 0; r < 8; ++r) p0[r] = fast_exp2(p0[r]);
    PV_D0(3);
#pragma unroll
    for (int r = 8; r < 16; ++r) p0[r] = fast_exp2(p0[r]);
#undef PV_D0
#undef TRRD
}

template <int VOFF>
__device__ __forceinline__ void pv_exp(f32x16* o, int vb, bf16x8 pa0, bf16x8 pa1, bf16x8 pa2, bf16x8 pa3, f32x16& p0) {
#define TRRD(dst, off) asm volatile("ds_read_b64_tr_b16 %0, %1 offset:%2" : "=&v"(dst) : "v"(vb), "i"(off) : "memory")
#define PV_D0(d0) do { s16x4 l0, l1, l2, l3, h0, h1, h2, h3; constexpr int b_ = VOFF + v_rd_off(d0, 0, 0); \
        TRRD(l0, b_); TRRD(h0, b_ + 2048); TRRD(l1, b_ + 4096); TRRD(h1, b_ + 6144); TRRD(l2, b_ + 8192); TRRD(h2, b_ + 10240); TRRD(l3, b_ + 12288); TRRD(h3, b_ + 14336); \
        asm volatile("s_waitcnt lgkmcnt(0)" ::: "memory"); SBAR(); \
        o[d0] = __builtin_amdgcn_mfma_f32_32x32x16_bf16(pa0, (bf16x8){l0[0], l0[1], l0[2], l0[3], h0[0], h0[1], h0[2], h0[3]}, o[d0], 0, 0, 0); \
        o[d0] = __builtin_amdgcn_mfma_f32_32x32x16_bf16(pa1, (bf16x8){l1[0], l1[1], l1[2], l1[3], h1[0], h1[1], h1[2], h1[3]}, o[d0], 0, 0, 0); \
        o[d0] = __builtin_amdgcn_mfma_f32_32x32x16_bf16(pa2, (bf16x8){l2[0], l2[1], l2[2], l2[3], h2[0], h2[1], h2[2], h2[3]}, o[d0], 0, 0, 0); \
        o[d0] = __builtin_amdgcn_mfma_f32_32x32x16_bf16(pa3, (bf16x8){l3[0], l3[1], l3[2], l3[3], h3[0], h3[1], h3[2], h3[3]}, o[d0], 0, 0, 0); \
        _Pragma("unroll") for (int r = 4 * (d0); r < 4 * (d0) + 4; ++r) p0[r] = fast_exp2(p0[r]); } while (0)
    PV_D0(0); PV_D0(1); PV_D0(2); PV_D0(3);
#undef PV_D0
#undef TRRD
}

constexpr int FOX_NB = 131072, FOX_WS = 132096, FOX_ML = 134144;
#define WAIT_BAR() asm volatile("s_waitcnt vmcnt(0) lgkmcnt(0)\n\ts_barrier" ::: "memory")
__device__ __forceinline__ void fox_unit(const bf16_t* __restrict__ Zb, int h, int i, int t0, const float* __restrict__ cum, bf16_t* __restrict__ Yb, lptr lds) {
    int tid_ = threadIdx.x; asm volatile("" : "+v"(tid_));
    const int tid = tid_, wid = __builtin_amdgcn_readfirstlane(tid >> 6), lane = tid & 63, r32 = lane & 31, hi = lane >> 5;
    const int hb = wid >> 2, w4 = wid & 3, th = tid & 255;
    const int NT = i + 1 - t0, q0 = 128 * i;
    lptr V_lds = lds + hb * 65536; lptr K_lds = V_lds + 2 * SHM_T;
    LAS float* nbuf = (LAS float*)(lds + FOX_NB) + hb * 128;
    LAS float* wsf = (LAS float*)(lds + FOX_WS) + wid * 64; LAS float* li_l = wsf; LAS float* al_l = wsf + 32;
    const int qlo = q0 + 32 * w4, qm = qlo + r32 - 4 * hi;
    bf16x8 qr[8];
    { const bf16_t* Qw = Zb + (size_t)(qlo + r32) * EVEN_N + 1024 + h * 128 + hi * 8;
#pragma unroll
      for (int d0 = 0; d0 < 8; ++d0) qr[d0] = *(const bf16x8*)(Qw + d0 * 16); }
    const char* Kh = (const char*)(Zb + 1536 + h * 128); const char* Vh = (const char*)(Zb + 2048 + h * 128);
    const float cref = cum[q0];
    const int krow = 4 * w4 + (lane >> 4);
    const unsigned voffK = (unsigned)(krow * (EVEN_N * 2) + (((lane & 15) * 16) ^ ((krow & 7) << 4)));
    const int vrow = ((lane >> 2) & 3) + 4 * ((lane >> 4) & 1) + 8 * (w4 >> 1);
    const unsigned voffV = (unsigned)(vrow * (EVEN_N * 2) + (32 * (2 * (w4 & 1) + (lane >> 5)) + 8 * (lane & 3)) * 2);
    const int vb0 = (int)(uintptr_t)V_lds + v_rd_base(lane);
    float st_n = 0.f;
#define KBASE(t) ((2 * ((t) + t0) + hb) * 64)
#define DMA_K(t, bf) do { const char* tb_ = Kh + (size_t)KBASE(t) * (EVEN_N * 2); _Pragma("unroll") for (int j = 0; j < 4; ++j) \
        __builtin_amdgcn_global_load_lds((const unsigned*)(tb_ + (size_t)j * (16 * EVEN_N * 2) + voffK), (LAS unsigned*)(K_lds + (bf) * SHM_T + (j * 4 + w4) * 1024), 16, 0, 0); } while (0)
#define DMA_V(t, bf) do { const char* tb_ = Vh + (size_t)KBASE(t) * (EVEN_N * 2); _Pragma("unroll") for (int j = 0; j < 4; ++j) \
        __builtin_amdgcn_global_load_lds((const unsigned*)(tb_ + (size_t)j * (16 * EVEN_N * 2) + voffV), (LAS unsigned*)(V_lds + (bf) * SHM_T + (j * 4 + w4) * 1024), 16, 0, 0); } while (0)
#define NB_LOAD(t) do { if (th < 64) st_n = cum[KBASE(t) + th]; } while (0)
#define NB_WRITE(bf) do { if (th < 64) nbuf[(bf) * 64 + th] = (cref - st_n) * LOG2E; } while (0)
#define RESC(a) do { if (__any((a) < 1.f)) { if (hi == 0) al_l[r32] = (a); asm volatile("s_waitcnt lgkmcnt(0)" ::: "memory"); \
        _Pragma("unroll") for (int d_ = 0; d_ < 4; ++d_) _Pragma("unroll") for (int r = 0; r < 16; ++r) o[d_][r] *= al_l[crow(r, hi)]; } } while (0)
#define INIT(P0, P1, t, bf) do { const int kb_ = KBASE(t); if (kb_ + 63 > qlo) fox_init<true>(P0, P1, nbuf + (bf) * 64, hi, qm - kb_); else fox_init<false>(P0, P1, nbuf + (bf) * 64, hi, 0); } while (0)
    float m_reg = 0.f, l_reg = 0.f; f32x16 o[4] = {};
    f32x16 pA0, pA1, pB0, pB1; float alA, alB; bf16x8 pa0, pa1, pa2, pa3;
    const bf16x8 kone = kone_frag(hi); bf16x8 qx = {0, 0, 0, 0, 0, 0, 0, 0};
    DMA_K(0, 0); DMA_V(0, 0); NB_LOAD(0); NB_WRITE(0); WAIT_BAR();
    if (NT > 1) { DMA_K(1, 1); NB_LOAD(1); }
    INIT(pA0, pA1, 0, 0);
    SBAR(); qkt128(pA0, pA1, K_lds, r32, hi, qr, kone, qx);
    partialSM<true>(pA0, pA1, m_reg, l_reg, alA, qx, hi);
    if (NT > 1) NB_WRITE(1);
    WAIT_BAR();
    if (NT > 1) DMA_V(1, 1);
#define STEP(PX0, PX1, alX, PY0, PY1, alY, t, KB) do { \
        const bool more_ = (t) + 1 < NT; \
        if (more_) { DMA_K((t) + 1, 1 - (KB)); NB_LOAD((t) + 1); } \
        INIT(PX0, PX1, (t), (KB)); \
        SBAR(); qkt128(PX0, PX1, K_lds + (KB) * SHM_T, r32, hi, qr, kone, qx); \
        finishSM(PY0, PY1, l_reg, pa0, pa1, pa2, pa3); SBAR(); \
        pv_sm<(1 - (KB)) * SHM_T>(o, vb0, pa0, pa1, pa2, pa3, PX0, PX1, m_reg, l_reg, alX, qx, hi); \
        if (more_) NB_WRITE(1 - (KB)); \
        WAIT_BAR(); \
        if (more_) DMA_V((t) + 1, 1 - (KB)); \
        RESC(alX); } while (0)
    int t = 1;
    for (; t + 1 < NT; t += 2) {
        STEP(pB0, pB1, alB, pA0, pA1, alA, t, 1);
        STEP(pA0, pA1, alA, pB0, pB1, alB, t + 1, 0);
    }
    if ((NT & 1) == 0) {
        STEP(pB0, pB1, alB, pA0, pA1, alA, NT - 1, 1);
        finishSM(pB0, pB1, l_reg, pa0, pa1, pa2, pa3); SBAR(); pv_tile<SHM_T>(o, vb0, pa0, pa1, pa2, pa3);
    } else {
        finishSM(pA0, pA1, l_reg, pa0, pa1, pa2, pa3); SBAR(); pv_tile<0>(o, vb0, pa0, pa1, pa2, pa3);
    }
    WAIT_BAR();
    {
        int t2 = threadIdx.x; asm volatile("" : "+v"(t2));
        const int wid2 = __builtin_amdgcn_readfirstlane(t2 >> 6), lane2 = t2 & 63, r2 = lane2 & 31, hi2 = lane2 >> 5, hb2 = wid2 >> 2, w2 = wid2 & 3;
        LAS float* mrg = (LAS float*)(lds + 65536) + w2 * 4096; LAS float* mlB = (LAS float*)(lds + FOX_ML) + w2 * 64;
        LAS float* sc2 = (LAS float*)(lds + FOX_WS) + wid2 * 64;
        if (hb2 == 1) {
#pragma unroll
            for (int d0 = 0; d0 < 4; ++d0)
#pragma unroll
                for (int r = 0; r < 16; ++r) mrg[(d0 * 16 + r) * 64 + lane2] = o[d0][r];
            if (hi2 == 0) { mlB[r2] = m_reg; mlB[32 + r2] = l_reg; }
        }
        WAIT_BAR();
        if (hb2 == 0) {
            const float mb = mlB[r2], lb = mlB[32 + r2];
            const float Mx = fmaxf(m_reg, mb), fa = fast_exp2(m_reg - Mx), fb = fast_exp2(mb - Mx), inv = 1.0f / (l_reg * fa + lb * fb);
            if (hi2 == 0) { sc2[r2] = fa * inv; sc2[32 + r2] = fb * inv; }
            asm volatile("s_waitcnt lgkmcnt(0)" ::: "memory");
            LAS bf16_t* stg = (LAS bf16_t*)(lds + w2 * 8704);
#pragma unroll
            for (int r = 0; r < 16; ++r) { const int orow = crow(r, hi2); const float sa = sc2[orow], sb = sc2[32 + orow];
#pragma unroll
                for (int d0 = 0; d0 < 4; ++d0) { const float v = o[d0][r] * sa + mrg[(d0 * 16 + r) * 64 + lane2] * sb;
                    stg[orow * 136 + d0 * 32 + r2] = (bf16_t)(cvt_pk_bf16(v, 0.f) & 0xffffu); } }
            asm volatile("s_waitcnt lgkmcnt(0)" ::: "memory");
            bf16_t* yo = Yb + (size_t)(128 * i + 32 * w2) * D + 512 + h * 128;
#pragma unroll
            for (int it = 0; it < 8; ++it) { const int row = it * 4 + (lane2 >> 4), ch = lane2 & 15;
                const u32x4 v = *(const LAS u32x4*)((lptr)stg + row * 272 + ch * 16);
                *(u32x4*)(yo + (size_t)row * D + ch * 8) = v; }
        }
        WAIT_BAR();
    }
#undef KBASE
#undef DMA_K
#undef DMA_V
#undef NB_LOAD
#undef NB_WRITE
#undef RESC
#undef INIT
#undef STEP
}

constexpr int DF_LUT = 137216, DF_MRG = 69632, DF_WS = 135168;
#define KSWZ64(row, colB) ((row) * 128 + ((colB) ^ (((row) & 7) << 4)))
__device__ __forceinline__ void kload64(bf16x8* kf, lptr Kt, int r32, int hi) {
#pragma unroll
    for (int d0 = 0; d0 < 4; ++d0) { lptr a = Kt + KSWZ64(r32, d0 * 32 + hi * 16); kf[2 * d0] = *(const LAS bf16x8*)(a); kf[2 * d0 + 1] = *(const LAS bf16x8*)(a + 32 * 128); }
}
__device__ __forceinline__ void qkt64(f32x16& p0, f32x16& p1, const bf16x8* kf, const bf16x8* qr) {
#pragma unroll
    for (int d0 = 0; d0 < 4; ++d0) {
        p0 = __builtin_amdgcn_mfma_f32_32x32x16_bf16(kf[2 * d0], qr[d0], p0, 0, 0, 0);
        p1 = __builtin_amdgcn_mfma_f32_32x32x16_bf16(kf[2 * d0 + 1], qr[d0], p1, 0, 0, 0); }
}
__device__ __forceinline__ void diff_unit(const bf16_t* __restrict__ Zb, int h, int i, const float* __restrict__ relb, const float* __restrict__ gain, float lam, float post, bf16_t* __restrict__ Yb, lptr lds, const gu32* nrm  ) {
    int tid_ = threadIdx.x; asm volatile("" : "+v"(tid_));
    const int tid = tid_, wid = __builtin_amdgcn_readfirstlane(tid >> 6), lane = tid & 63, r32 = lane & 31, hi = lane >> 5;
    const int hb = wid >> 2, w4 = wid & 3;
    const int NT = 2 * (i + 1), q0 = 128 * i, qlo = q0 + 32 * w4, cq = qlo >> 6;
    lptr V_lds = lds; lptr K_lds = lds + 49152 + hb * 16384;
    LAS float* lut = (LAS float*)(lds + DF_LUT) + hb * 192;
    LAS float* wsf = (LAS float*)(lds + DF_WS) + wid * 64; LAS float* al_l = wsf + 32;
    float nB;
    { const gu32* np_ = nrm + ((0 * 2 + hb) * 4 + h) * 2; const gu32* nk_ = nrm + ((1 * 2 + hb) * 4 + h) * 2;
      const float nq = __uint_as_float(__hip_atomic_load(np_, RLX_AGENT)) + __uint_as_float(__hip_atomic_load(np_ + 1, RLX_AGENT));
      const float nk = __uint_as_float(__hip_atomic_load(nk_, RLX_AGENT)) + __uint_as_float(__hip_atomic_load(nk_ + 1, RLX_AGENT));
      const float lm = wave_max0((lane < 32) ? (relb[lane * 4 + h] - relb[15 * 4 + h]) * LOG2E : 0.f);
      nB = -(1.03f * sqrtf(nq) * sqrtf(nk) + lm + 0.5f); nB = __builtin_bit_cast(float, __builtin_amdgcn_readfirstlane(__builtin_bit_cast(int, nB))); }
    { const int li = w4 * 64 + lane; if (li < 192) lut[li] = (relb[rel_bucket(li - 128) * 4 + h] - relb[15 * 4 + h]) * LOG2E + nB; }
    bf16x8 qr[4];
    { const bf16_t* Qw = Zb + (size_t)(qlo + r32) * ODD_IN + hb * 256 + h * 64 + hi * 8;
#pragma unroll
      for (int d0 = 0; d0 < 4; ++d0) qr[d0] = *(const bf16x8*)(Qw + d0 * 16); }
    const char* Kh = (const char*)(Zb + 512 + hb * 256 + h * 64); const char* Vh = (const char*)(Zb + 1024 + h * 128);
    const int krow = 8 * w4 + (lane >> 3);
    const unsigned voffK = (unsigned)(krow * (ODD_IN * 2) + (((lane & 7) * 16) ^ ((krow & 7) << 4)));
    const int vrow = 16 * (wid >> 2) + ((lane >> 2) & 3) + 4 * ((lane >> 4) & 1) + 8 * ((wid >> 1) & 1);
    const unsigned voffV = (unsigned)(vrow * (ODD_IN * 2) + (32 * (2 * (wid & 1) + (lane >> 5)) + 8 * (lane & 3)) * 2);
    const int vb0 = (int)(uintptr_t)V_lds + v_rd_base(lane);
    const int lbase = 128 - qlo - r32 + 4 * hi;
#define DMA_K(t, bf) do { const char* tb_ = Kh + (size_t)(t) * (64 * ODD_IN * 2); _Pragma("unroll") for (int j = 0; j < 2; ++j) \
        __builtin_amdgcn_global_load_lds((const unsigned*)(tb_ + (size_t)j * (32 * ODD_IN * 2) + voffK), (LAS unsigned*)(K_lds + (bf) * 8192 + (j * 4 + w4) * 1024), 16, 0, 0); } while (0)
#define DMA_V(t, bf) do { const char* tb_ = Vh + (size_t)(t) * (64 * ODD_IN * 2); _Pragma("unroll") for (int j = 0; j < 2; ++j) \
        __builtin_amdgcn_global_load_lds((const unsigned*)(tb_ + (size_t)j * (32 * ODD_IN * 2) + voffV), (LAS unsigned*)(V_lds + (bf) * SHM_T + (j * 8 + wid) * 1024), 16, 0, 0); } while (0)
#define INIT(P0, P1, t) do { const int kb_ = (t) * 64; \
        if ((t) > cq) { const float ng_ = -__builtin_inff(); _Pragma("unroll") for (int r = 0; r < 16; ++r) { P0[r] = ng_; P1[r] = ng_; } } \
        else if (kb_ + 63 <= qlo - 128) { _Pragma("unroll") for (int r = 0; r < 16; ++r) { P0[r] = nB; P1[r] = nB; } } \
        else { const int ib_ = lbase + kb_; _Pragma("unroll") for (int r = 0; r < 16; ++r) { const int ix_ = ib_ + (r & 3) + 8 * (r >> 2); P0[r] = lut[ix_ < 0 ? 0 : ix_]; P1[r] = lut[ix_ + 32 < 0 ? 0 : ix_ + 32]; } } } while (0)
    float l_reg = 0.f; f32x16 o[4] = {};
    f32x16 pA0, pA1, pB0, pB1; bf16x8 pa0, pa1, pa2, pa3;
    DMA_K(0, 0); DMA_V(0, 0); WAIT_BAR();
    DMA_K(1, 1);
    bf16x8 kf[8];
    kload64(kf, K_lds, r32, hi); INIT(pA0, pA1, 0); SBAR(); qkt64(pA0, pA1, kf, qr);
#pragma unroll
    for (int r = 0; r < 16; ++r) pA0[r] = fast_exp2(pA0[r]);
    WAIT_BAR();
    DMA_V(1, 1);
#define SF(PX0, PX1, PY0, PY1, t, KB) do { kload64(kf, K_lds + (KB) * 8192, r32, hi); SBAR(); INIT(PX0, PX1, (t)); SBAR(); \
        qkt64(PX0, PX1, kf, qr); finishSM(PY0, PY1, l_reg, pa0, pa1, pa2, pa3); SBAR(); } while (0)
#define STEP(HB, PX0, PX1, PY0, PY1, t, KB) do { \
        const bool more_ = (t) + 1 < NT; const int vm1 = s1, vm2 = s1 == 0 ? 2 : s1 - 1;        \
        if ((HB) == 0) { if (more_) DMA_K((t) + 1, 1 - (KB)); SF(PX0, PX1, PY0, PY1, (t), (KB)); pv_exp<0>(o, vb0 + vm1 * SHM_T, pa0, pa1, pa2, pa3, PX0); } \
        else { if ((t) >= 2) pv_exp<0>(o, vb0 + vm2 * SHM_T, pa0, pa1, pa2, pa3, PY0); if (more_) DMA_K((t) + 1, 1 - (KB)); SF(PX0, PX1, PY0, PY1, (t), (KB)); } \
        WAIT_BAR(); \
        if (more_) DMA_V((t) + 1, vm2); \
        s1 = s1 == 2 ? 0 : s1 + 1; } while (0)
#define LOOP(HB) do { int s1 = 0;   int t = 1; \
        for (; t + 1 < NT; t += 2) { STEP(HB, pB0, pB1, pA0, pA1, t, 1); STEP(HB, pA0, pA1, pB0, pB1, t + 1, 0); } \
        STEP(HB, pB0, pB1, pA0, pA1, NT - 1, 1); \
        { const int vl = s1, vl2 = s1 == 0 ? 2 : s1 - 1;        \
          if ((HB) == 0) { finishSM(pB0, pB1, l_reg, pa0, pa1, pa2, pa3); SBAR(); pv_tile<0>(o, vb0 + vl * SHM_T, pa0, pa1, pa2, pa3); } \
          else { pv_exp<0>(o, vb0 + vl2 * SHM_T, pa0, pa1, pa2, pa3, pB0); finishSM(pB0, pB1, l_reg, pa0, pa1, pa2, pa3); SBAR(); pv_tile<0>(o, vb0 + vl * SHM_T, pa0, pa1, pa2, pa3); } } } while (0)
    if (hb == 0) LOOP(0); else LOOP(1);
    WAIT_BAR();
    {
        int t2 = threadIdx.x; asm volatile("" : "+v"(t2));
        const int wid2 = __builtin_amdgcn_readfirstlane(t2 >> 6), lane2 = t2 & 63, r2 = lane2 & 31, hi2 = lane2 >> 5, hb2 = wid2 >> 2, w2 = wid2 & 3;
        LAS float* mrg = (LAS float*)(lds + DF_MRG) + w2 * 4096; LAS float* sc2 = (LAS float*)(lds + DF_WS) + wid2 * 64;
        if (hi2 == 0) sc2[r2] = (hb2 ? lam : 1.0f) / l_reg;
        asm volatile("s_waitcnt lgkmcnt(0)" ::: "memory");
        if (hb2 == 1) {
#pragma unroll
            for (int r = 0; r < 16; ++r) { const float sb = sc2[crow(r, hi2)];
#pragma unroll
                for (int d0 = 0; d0 < 4; ++d0) mrg[(d0 * 16 + r) * 64 + lane2] = o[d0][r] * sb; }
        }
        WAIT_BAR();
        if (hb2 == 0) {
            LAS float* stg = (LAS float*)(lds + w2 * 16896);
#pragma unroll
            for (int r = 0; r < 16; ++r) { const int orow = crow(r, hi2); const float sa = sc2[orow];
#pragma unroll
                for (int d0 = 0; d0 < 4; ++d0) stg[orow * 132 + d0 * 32 + r2] = o[d0][r] * sa - mrg[(d0 * 16 + r) * 64 + lane2]; }
            asm volatile("s_waitcnt lgkmcnt(0)" ::: "memory");
            const int row = lane2 >> 1, hc = lane2 & 1;
            const LAS f32x4* sp = (const LAS f32x4*)(stg + row * 132 + hc * 64);
            f32x4 v[16]; float ss = 0.f;
#pragma unroll
            for (int k = 0; k < 16; ++k) { v[k] = sp[k]; ss += (v[k][0] * v[k][0] + v[k][1] * v[k][1]) + (v[k][2] * v[k][2] + v[k][3] * v[k][3]); }
            ss += __shfl_xor(ss, 1);
            const float rr = post / sqrtf(ss * (1.0f / 128.0f) + EPS);
            const f32x4* gp = (const f32x4*)(gain + h * 128 + hc * 64);
            bf16_t* yo = Yb + (size_t)(128 * i + 32 * w2 + row) * D + h * 128 + hc * 64;
#pragma unroll
            for (int k = 0; k < 8; ++k) { const f32x4 g0 = gp[2 * k], g1 = gp[2 * k + 1]; const f32x4 a = v[2 * k] * g0 * rr, b = v[2 * k + 1] * g1 * rr;
                u32x4 w; w.x = cvt_pk_bf16(a[0], a[1]); w.y = cvt_pk_bf16(a[2], a[3]); w.z = cvt_pk_bf16(b[0], b[1]); w.w = cvt_pk_bf16(b[2], b[3]);
                *(u32x4*)(yo + 8 * k) = w; }
        }
        WAIT_BAR();
    }
#undef DMA_K
#undef DMA_V
#undef INIT
#undef SF
#undef STEP
#undef LOOP
}

__device__ __forceinline__ void gmlp_unit(const bf16_t* __restrict__ Zb  , int gp, const float* __restrict__ Wg, const float* __restrict__ bs, const float* __restrict__ vgain, bf16_t* __restrict__ Yb, lptr lds) {
    int tid_ = threadIdx.x; asm volatile("" : "+v"(tid_));
    const int tid = tid_, wid = __builtin_amdgcn_readfirstlane(tid >> 6), lane = tid & 63, r32 = lane & 31, hi = lane >> 5;
    const int gs = wid >> 2, w4 = wid & 3, g = 2 * gp + gs;
    { const int sg = wid >> 2, gg = 2 * gp + sg, j0 = (wid & 3) * 32;
      unsigned wv[32];
#pragma unroll
      for (int rr = 0; rr < 32; ++rr) wv[rr] = *(const unsigned*)(Zb + (size_t)(j0 + rr) * EVEN_N + 512 + gg * 128 + 2 * lane);
      const f32x2 gn = *(const f32x2*)(vgain + gg * 128 + 2 * lane);
#pragma unroll
      for (int rr = 0; rr < 32; ++rr) { const int j = j0 + rr;
        const float a = bflo(wv[rr]), b = bfhi(wv[rr]); const float ss = wave_sum(a * a + b * b); const float r = 1.0f / sqrtf(ss * (1.0f / 128.0f) + EPS);
        *(LAS unsigned*)(lds + sg * 32768 + (j >> 6) * SHM_T + v_st(j & 63, 2 * lane)) = cvt_pk_bf16(a * r * gn[0], b * r * gn[1]); } }
    WAIT_BAR();
    f32x16 o[4] = {};
    const int vb = (int)(uintptr_t)(lds + gs * 32768) + v_rd_base(lane);
    const float* wrow = Wg + ((size_t)g * 128 + 32 * w4 + r32) * 128 + 8 * hi;
#define WFRAG(ks) ({ const f32x4 x0_ = *(const f32x4*)(wrow + 16 * (ks)), x1_ = *(const f32x4*)(wrow + 16 * (ks) + 4); \
        u32x4 w_ = {cvt_pk_bf16(x0_[0], x0_[1]), cvt_pk_bf16(x0_[2], x0_[3]), cvt_pk_bf16(x1_[0], x1_[1]), cvt_pk_bf16(x1_[2], x1_[3])}; *reinterpret_cast<bf16x8*>(&w_); })
    { const bf16x8 a0 = WFRAG(0), a1 = WFRAG(1), a2 = WFRAG(2), a3 = WFRAG(3);
      bf16x8 a4 = a0, a5 = a0, a6 = a0, a7 = a0; if (w4 >= 2) { a4 = WFRAG(4); a5 = WFRAG(5); a6 = WFRAG(6); a7 = WFRAG(7); }
      pv_tile<0>(o, vb, a0, a1, a2, a3);
      if (w4 >= 2) pv_tile<SHM_T>(o, vb, a4, a5, a6, a7); }
#undef WFRAG
    LAS bf16_t* stg = (LAS bf16_t*)(lds + 65536 + wid * 8704);
#pragma unroll
    for (int r = 0; r < 16; ++r) { const int orow = crow(r, hi); const float bb = bs[g * 128 + 32 * w4 + orow];
#pragma unroll
        for (int d0 = 0; d0 < 4; ++d0) stg[orow * 136 + d0 * 32 + r32] = (bf16_t)(cvt_pk_bf16(o[d0][r] + bb, 0.f) & 0xffffu); }
    asm volatile("s_waitcnt lgkmcnt(0)" ::: "memory");
    u32x4 uq[8];
#pragma unroll
    for (int it = 0; it < 8; ++it) uq[it] = *(const u32x4*)(Zb + (size_t)(32 * w4 + it * 4 + (lane >> 4)) * EVEN_N + g * 128 + (lane & 15) * 8);
#pragma unroll
    for (int it = 0; it < 8; ++it) { const int row = it * 4 + (lane >> 4), ch = lane & 15;
        const u32x4 mx = *(const LAS u32x4*)((lptr)stg + row * 272 + ch * 16);
        const u32x4 uu = uq[it];
        u32x4 w; w.x = cvt_pk_bf16(bflo(mx.x) * bflo(uu.x), bfhi(mx.x) * bfhi(uu.x)); w.y = cvt_pk_bf16(bflo(mx.y) * bflo(uu.y), bfhi(mx.y) * bfhi(uu.y));
        w.z = cvt_pk_bf16(bflo(mx.z) * bflo(uu.z), bfhi(mx.z) * bfhi(uu.z)); w.w = cvt_pk_bf16(bflo(mx.w) * bflo(uu.w), bfhi(mx.w) * bfhi(uu.w));
        *(u32x4*)(Yb + (size_t)(32 * w4 + row) * D + g * 128 + ch * 8) = w; }
    WAIT_BAR();
}
}

constexpr int NPHASE = 18;
struct Args { const float* in[32]; float* out; unsigned char* ws; int ph_lo, ph_hi; };

__global__ void __launch_bounds__(512, 2) mk_fwd(Args args) {
    extern __shared__ __attribute__((aligned(16))) unsigned char lds_raw[];
    LAS unsigned char* lds = (LAS unsigned char*)lds_raw;
    volatile LAS unsigned* MISC = (volatile LAS unsigned*)(lds + MISC_OFF);
    const int G = gridDim.x, bx = blockIdx.x, NGW = G * 8;
    for (int u = threadIdx.x; u < 64; u += 512) MISC[u] = 0u;
    __syncthreads();
#define KARG_T const __attribute__((address_space(4))) char*
#define PHASE_BEGIN() KARG_T ka = (KARG_T)__builtin_amdgcn_kernarg_segment_ptr(); asm volatile("" : "+s"(ka)); \
    unsigned char* ws = *(unsigned char* const __attribute__((address_space(4)))*)(ka + 264); \
    int tid = threadIdx.x; asm volatile("" : "+v"(tid)); const int lane = tid & 63, wave = __builtin_amdgcn_readfirstlane(tid >> 6); const int gw = bx * 8 + wave; (void)lane; (void)gw; (void)ws
#define ARG_IN(k) (*(const float* const __attribute__((address_space(4)))*)(ka + 8 * (k)))
#define ARG_OUT (*(float* const __attribute__((address_space(4)))*)(ka + 256))
#if !MK_PER_PHASE
    XcdBarrier bar = xcd_barrier_post((unsigned*)(args.ws + WS_CTL) + CW_BAR, MISC + 8);
#define GRID_BAR() xcd_barrier(bar)
#else
#define GRID_BAR() do {} while (0)
#endif
    const int lo = args.ph_lo, hi = args.ph_hi;
#ifndef MK_PHASE_MASK
#define MK_PHASE_MASK 0xFFFFFFFFu
#endif
#define IN(k) ((((MK_PHASE_MASK) >> (k)) & 1u) && lo <= (k) && (k) < hi)
#define SEAM(k) do { if (IN(k) && IN((k) + 1)) GRID_BAR(); } while (0)
#if !MK_PER_PHASE
#define SEAM_F(k) do { if (IN(k) && IN((k) + 1)) { PHASE_BEGIN(); xcd_barrier_arrive(bar); MOE_CONVERT(MK_QS); xcd_barrier_wait(bar); } } while (0)
#else
#define SEAM_F(k) SEAM(k)
#endif
#ifndef MK_DUP
#define MK_DUP (-1)
#endif
#define REPS(k) ((MK_DUP == (k)) ? 2 : 1)
#define DUP_BAR(k) do { if (rep_ + 1 < REPS(k)) GRID_BAR(); } while (0)

#define x_in ARG_IN(0)
#define mem_in ARG_IN(1)
#define norm_mix ARG_IN(2)
#define norm_mem_q ARG_IN(3)
#define norm_mem_kv ARG_IN(4)
#define norm_ffn ARG_IN(5)
#define norm_final ARG_IN(6)
#define even_w_in ARG_IN(7)
#define fox_b_f ARG_IN(8)
#define gmlp_v_gain ARG_IN(9)
#define gmlp_w_s ARG_IN(10)
#define gmlp_b_s ARG_IN(11)
#define even_w_out ARG_IN(12)
#define odd_w_in ARG_IN(13)
#define lq1 ARG_IN(14)
#define lk1 ARG_IN(15)
#define lq2 ARG_IN(16)
#define lk2 ARG_IN(17)
#define subln_gain ARG_IN(18)
#define conv_w ARG_IN(19)
#define odd_w_out ARG_IN(20)
#define rel_bias ARG_IN(21)
#define mem_w_q ARG_IN(22)
#define mem_w_kv ARG_IN(23)
#define mem_w_o ARG_IN(24)
#define ffn_w_gate ARG_IN(25)
#define ffn_w_up ARG_IN(26)
#define ffn_w_down ARG_IN(27)
#define router_w ARG_IN(28)
#define moe_w_gate ARG_IN(29)
#define moe_w_up ARG_IN(30)
#define moe_w_down ARG_IN(31)
#define XF ARG_OUT
#define CNT ((int*)(ws + WS_CNT))
#define TOKE ((unsigned*)(ws + WS_TOKE))
#define GATE ((float*)(ws + WS_GATE))
#define SLOT ((int*)(ws + WS_SLOT))
#define RS5 ((float*)(ws + WS_RS5))
#define RSS ((float*)(ws + WS_RSS))
#define FL ((float*)(ws + WS_FL))
#define CUM ((float*)(ws + WS_CUM))
#define SSP0 ((float*)(ws + WS_SSP))
#define SSP1 ((float*)(ws + WS_SSP + SSP_BYTES))
#define SSP2 ((float*)(ws + WS_SSP + 2 * SSP_BYTES))
#define SSP3 ((float*)(ws + WS_SSP + 3 * SSP_BYTES))
#define SSP4 ((float*)(ws + WS_SSP + 4 * SSP_BYTES))
#define WGUE ((bf16_t*)(ws + WS_WGUE))
#define WDE ((bf16_t*)(ws + WS_WDE))
#define YMOE ((bf16_t*)(ws + WS_YMOE))
#define WIN0 ((bf16_t*)(ws + WS_WIN0))
#define WOUT0 ((bf16_t*)(ws + WS_WOUT0))
#define WIN1 ((bf16_t*)(ws + WS_WIN1))
#define WOUT1 ((bf16_t*)(ws + WS_WOUT1))
#define WKV ((bf16_t*)(ws + WS_WKV))
#define WQG ((bf16_t*)(ws + WS_WQG))
#define WOT ((bf16_t*)(ws + WS_WOT))
#define WGU0 ((bf16_t*)(ws + WS_WGU0))
#define WD0 ((bf16_t*)(ws + WS_WD0))
#define MEMN ((bf16_t*)(ws + WS_MEMN))
#define KV ((bf16_t*)(ws + WS_KV))
#define AT ((bf16_t*)(ws + WS_AT))
#define BT ((bf16_t*)(ws + WS_BT))
#define XB ((bf16_t*)(ws + WS_XB))
#define Y ((bf16_t*)(ws + WS_Y))
#define Z ((bf16_t*)(ws + WS_Z))
#define AMOE ((bf16_t*)(ws + WS_AMOE))
#define HMOE ((bf16_t*)(ws + WS_HMOE))

    if (IN(0))
#pragma unroll 1
    for (int rep_ = 0; rep_ < REPS(0); ++rep_) {
        PHASE_BEGIN();
        LAS Job* jobs = (LAS Job*)(lds + JOB_OFF); LAS int* jtot = (LAS int*)(lds + JOB_OFF + NJOBS * 48);
        constexpr int NJ0 = 11;
        if (tid < NJ0) {
            Job jb; jb.pad = 0; jb.start = 0; const int j = tid;
            if (j == 0) { jb.src = even_w_in; jb.gain = norm_mix; jb.dst = WIN0; jb.ld = EVEN_IN; jb.Kd = D; jb.nnb = EVEN_N / 64; jb.mode = 0; }
            else if (j == 1) { jb.src = even_w_out; jb.gain = nullptr; jb.dst = WOUT0; jb.ld = D; jb.Kd = D; jb.nnb = D / 64; jb.mode = 0; }
            else if (j == 2) { jb.src = odd_w_in; jb.gain = norm_mix + D; jb.dst = WIN1; jb.ld = ODD_IN; jb.Kd = D; jb.nnb = ODD_IN / 64; jb.mode = 0; }
            else if (j == 3) { jb.src = odd_w_out; jb.gain = nullptr; jb.dst = WOUT1; jb.ld = D; jb.Kd = D; jb.nnb = D / 64; jb.mode = 0; }
            else if (j < 6) { const int l = j - 4; jb.src = mem_w_kv + (size_t)l * D * 2048; jb.gain = nullptr; jb.dst = WKV + (size_t)l * 2048 * D; jb.ld = 2048; jb.Kd = D; jb.nnb = 2048 / 64; jb.mode = 0; }
            else if (j < 8) { const int l = j - 6; jb.src = mem_w_o + (size_t)l * D * D; jb.gain = nullptr; jb.dst = WOT + (size_t)l * D * D; jb.ld = D; jb.Kd = D; jb.nnb = D / 64; jb.mode = 0; }
            else if (j == 8) { jb.src = ffn_w_gate; jb.gain = norm_ffn; jb.dst = WGU0; jb.ld = FF; jb.Kd = D; jb.nnb = FF / 64; jb.mode = 1; }
            else if (j == 9) { jb.src = ffn_w_up; jb.gain = norm_ffn; jb.dst = WGU0; jb.ld = FF; jb.Kd = D; jb.nnb = FF / 64; jb.mode = 2; }
            else if (j == 10) { jb.src = ffn_w_down; jb.gain = nullptr; jb.dst = WD0; jb.ld = D; jb.Kd = FF; jb.nnb = D / 64; jb.mode = 3; }
            else if (j < 19) { const int e = j - 11; jb.src = moe_w_gate + (size_t)e * D * FFE; jb.gain = norm_ffn + D; jb.dst = (bf16_t*)((unsigned char*)WGUE + (size_t)e * 2 * FFE * D * (MOE_FP8 ? 1 : 2)); jb.ld = FFE; jb.Kd = D; jb.nnb = FFE / 64; jb.mode = 1; }
            else if (j < 27) { const int e = j - 19; jb.src = moe_w_up + (size_t)e * D * FFE; jb.gain = norm_ffn + D; jb.dst = (bf16_t*)((unsigned char*)WGUE + (size_t)e * 2 * FFE * D * (MOE_FP8 ? 1 : 2)); jb.ld = FFE; jb.Kd = D; jb.nnb = FFE / 64; jb.mode = 2; }
            else { const int e = j - 27; jb.src = moe_w_down + (size_t)e * FFE * D; jb.gain = nullptr; jb.dst = (bf16_t*)((unsigned char*)WDE + (size_t)e * D * FFE * (MOE_FP8 ? 1 : 2)); jb.ld = D; jb.Kd = FFE; jb.nnb = D / 64; jb.mode = 4; }
            jobs[j].src = jb.src; jobs[j].gain = jb.gain; jobs[j].dst = jb.dst; jobs[j].ld = jb.ld; jobs[j].Kd = jb.Kd; jobs[j].nnb = jb.nnb; jobs[j].mode = jb.mode; jobs[j].start = 0; jobs[j].pad = 0;
        }
        __syncthreads();
        if (tid == 0) { int s = 0; for (int j = 0; j < NJ0; ++j) { const int nkb = (jobs[j].mode == 3 ? FF : (jobs[j].mode == 4 ? FFE : D)) / 64; jobs[j].start = s; s += nkb * jobs[j].nnb; } *jtot = s; }
        __syncthreads();
        {
            LAS float* scr = (LAS float*)(lds + wave * 16640);
            const int total = *jtot;
            for (int it = gw; it < total; it += NGW) {
                int j = 0;
                for (int q = 1; q < NJ0; ++q) if (jobs[q].start <= it) j = q;
                Job jb; jb.src = jobs[j].src; jb.gain = jobs[j].gain; jb.dst = jobs[j].dst; jb.ld = jobs[j].ld; jb.Kd = jobs[j].Kd; jb.nnb = jobs[j].nnb; jb.mode = jobs[j].mode; jb.start = jobs[j].start;
                const int local = it - jb.start, kb = local / jb.nnb, nb = local % jb.nnb, n0 = nb * 64;
                int drow0 = n0;
                if (jb.mode == 1) drow0 = 256 * (n0 >> 7) + (n0 & 127);
                if (jb.mode == 2) drow0 = 256 * (n0 >> 7) + 128 + (n0 & 127);
                tr_item(jb.src, jb.ld, kb * 64, n0, jb.gain, jb.dst, jb.Kd, drow0, scr, lane, FFN_D8 && jb.mode == 3);
            }
        }
        for (int i = bx * 512 + tid; i < 2 * D * D / 8; i += G * 512) {
            const int e0 = i * 8, l = e0 / (D * D), c = (e0 / D) % D; const float g = norm_mem_q[l * D + c];
            const f32x4 a = *(const f32x4*)(mem_w_q + e0) * g, b = *(const f32x4*)(mem_w_q + e0 + 4) * g;
            u32x4 o; o.x = cvt_pk_bf16(a[0], a[1]); o.y = cvt_pk_bf16(a[2], a[3]); o.z = cvt_pk_bf16(b[0], b[1]); o.w = cvt_pk_bf16(b[2], b[3]);
            *(u32x4*)(WQG + e0) = o;
        }
        for (int i = bx * 512 + tid; i < 8 * D; i += G * 512) { const int e = i >> 10, k = i & (D - 1); ((float*)(ws + WS_WRT))[i] = norm_ffn[D + k] * router_w[(size_t)k * 8 + e]; }
        {
            float wf[4][16];
            {
                LAS f32x4* wfl = (LAS f32x4*)(lds + 135 * 1024);
                __syncthreads();
                for (int k = tid; k < D; k += 512) wfl[k] = *(const f32x4*)(even_w_in + (size_t)k * EVEN_IN + EVEN_N) * norm_mix[k];
                __syncthreads();
#pragma unroll
                for (int j = 0; j < 4; ++j)
#pragma unroll
                    for (int e = 0; e < 4; ++e) { const f32x4 v = wfl[4 * lane + 256 * j + e]; wf[0][4 * j + e] = v[0]; wf[1][4 * j + e] = v[1]; wf[2][4 * j + e] = v[2]; wf[3][4 * j + e] = v[3]; }
            }
            for (int row = gw; row < M; row += NGW) {
                const f32x4* xr = (const f32x4*)(x_in + (size_t)row * D) + lane;
                f32x4 v[4]; float ss = 0.f, d0 = 0.f, d1 = 0.f, d2 = 0.f, d3 = 0.f;
#pragma unroll
                for (int j = 0; j < 4; ++j) { v[j] = xr[64 * j];
#pragma unroll
                    for (int e = 0; e < 4; ++e) { const float t = v[j][e]; ss += t * t; d0 += t * wf[0][4 * j + e]; d1 += t * wf[1][4 * j + e]; d2 += t * wf[2][4 * j + e]; d3 += t * wf[3][4 * j + e]; } }
                ss = wave_sum(ss); d0 = wave_sum(d0); d1 = wave_sum(d1); d2 = wave_sum(d2); d3 = wave_sum(d3);
                u32x2* o8 = (u32x2*)(XB + (size_t)row * D) + lane;
#pragma unroll
                for (int j = 0; j < 4; ++j) { u32x2 w; w.x = cvt_pk_bf16(v[j][0], v[j][1]); w.y = cvt_pk_bf16(v[j][2], v[j][3]); o8[64 * j] = w; }
                if (lane < 16) SSP0[(size_t)row * 16 + lane] = lane == 0 ? ss : 0.f;
                if (lane < 4) { const float r = 1.0f / sqrtf(ss * (1.0f / D) + EPS); const float dd = lane == 0 ? d0 : lane == 1 ? d1 : lane == 2 ? d2 : d3;
                    const float z = r * dd + fox_b_f[lane]; FL[(size_t)row * 4 + lane] = fminf(z, 0.f) - log1pf(expf(-fabsf(z))); }
            }
        }
        for (int R = gw; R < 2 * 512; R += NGW) {
            const int l = R / 512, rr = R % 512;
            const f32x4* xr = (const f32x4*)(mem_in + (size_t)rr * D) + lane; const f32x4* gr = (const f32x4*)(norm_mem_kv + l * D) + lane;
            f32x4 v[4]; float ss = 0.f;
#pragma unroll
            for (int j = 0; j < 4; ++j) { v[j] = xr[64 * j]; ss += (v[j][0] * v[j][0] + v[j][1] * v[j][1]) + (v[j][2] * v[j][2] + v[j][3] * v[j][3]); }
            ss = wave_sum(ss); const float r = 1.0f / sqrtf(ss * (1.0f / D) + EPS);
            u32x2* o8 = (u32x2*)(MEMN + (size_t)R * D) + lane;
#pragma unroll
            for (int j = 0; j < 4; ++j) { const f32x4 g = gr[64 * j]; u32x2 w; w.x = cvt_pk_bf16(v[j][0] * r * g[0], v[j][1] * r * g[1]); w.y = cvt_pk_bf16(v[j][2] * r * g[2], v[j][3] * r * g[3]); o8[64 * j] = w; }
        }
        __syncthreads();
        DUP_BAR(0);
    }
    SEAM(0);

    if (IN(1))
#pragma unroll 1
    for (int rep_ = 0; rep_ < REPS(1); ++rep_) {
        PHASE_BEGIN();
        {
            pg8::GridSched S; S.init(M / 256, EVEN_N / 256, G, bx, XB, (size_t)256 * D * 2, WIN0, (size_t)256 * D * 2, 256);
            pg8::EpiStore<1> E{Z, EVEN_N, SSP0, 0.08838834764831845f * LOG2E, (unsigned*)(ws + WS_CTL) + CW_NRM};
            pg8::gemm_phase<pg8::EpiStore<1>, pg8::GridSched, true>(lds, pg8::Gemm{D, D, D}, S, E);
        }
        {
            auto f = [=](int L, pg8::Unit& u) { const int l = L >> 4, pm = (L >> 3) & 1, pn = L & 7;
                u.a = (const char*)(MEMN + (size_t)(l * 512 + pm * 256) * D); u.b = (const char*)(WKV + (size_t)l * 2048 * D + (size_t)pn * 256 * D);
                u.orow = l * 512 + pm * 256; u.ocol = pn * 256; u.tag = 0; u.pad = 0; };
            pg8::ListSched<decltype(f)> S{32, G, G - 1 - bx, f};
            pg8::EpiStore<0> E{KV, 2048, nullptr, 1.0f, nullptr};
            pg8::gemm_phase<pg8::EpiStore<0>, pg8::ListSched<decltype(f)>, true>(lds, pg8::Gemm{D, D, D}, S, E);
        }
        if (bx >= G - 8 - 32 && bx < G - 32) {
            const int s = bx - (G - 8 - 32), b = s >> 2, h = s & 3;
            LAS float* part = (LAS float*)(lds + EPI_OFF);
            float v[16]; float run = 0.f;
#pragma unroll
            for (int i = 0; i < 16; ++i) { run += FL[(size_t)(b * SEQ + tid * 16 + i) * 4 + h]; v[i] = run; }
            float inc = run;
#pragma unroll
            for (int o = 1; o < 64; o <<= 1) { const float t = __shfl_up(inc, o); if (lane >= o) inc += t; }
            if (lane == 63) part[wave] = inc;
            __syncthreads();
            float base = inc - run;
            for (int w = 0; w < wave; ++w) base += part[w];
#pragma unroll
            for (int i = 0; i < 16; ++i) CUM[(size_t)s * SEQ + tid * 16 + i] = base + v[i];
            __syncthreads();
        }
        if (bx >= 128 && bx < G - 8 - 32) MOE_CONVERT(MK_Q1);
        DUP_BAR(1);
    }
    SEAM(1);

    if (IN(2))
#pragma unroll 1
    for (int rep_ = 0; rep_ < REPS(2); ++rep_) {
        PHASE_BEGIN();
        {
            auto f = [=](int L, pg8::Unit& u) { const int l = L >> 5, b = (L >> 4) & 1, h = (L >> 2) & 3, pn = L & 3;
                u.a = (const char*)(KV + (size_t)(l * 512 + b * 256) * 2048 + h * 256); u.b = (const char*)(WQG + (size_t)l * D * D + (size_t)pn * 256 * D + h * 256);
                u.orow = (l * 2 + b) * 1024 + h * 256; u.ocol = pn * 256; u.tag = 0; u.pad = 0; };
            pg8::ListSched<decltype(f)> S{64, G, bx, f};
            pg8::EpiStore<0> E{AT, D, nullptr, 0.0625f * LOG2E, nullptr};
            pg8::gemm_phase<pg8::EpiStore<0>, pg8::ListSched<decltype(f)>, true>(lds, pg8::Gemm{2048, D, 256}, S, E);
        }
        {
            auto f = [=](int L, pg8::Unit& u) { const int l = L >> 5, b = (L >> 4) & 1, h = (L >> 2) & 3, pm = L & 3;
                u.a = (const char*)(WOT + (size_t)l * D * D + (size_t)pm * 256 * D + h * 256); u.b = (const char*)(KV + (size_t)(l * 512 + b * 256) * 2048 + 1024 + h * 256);
                u.orow = (l * 2 + b) * 1024 + pm * 256; u.ocol = h * 256; u.tag = 0; u.pad = 0; };
            pg8::ListSched<decltype(f)> S{64, G, (bx + 64) % G, f};
            pg8::EpiStore<0> E{BT, D, nullptr, 1.0f, nullptr};
            pg8::gemm_phase<pg8::EpiStore<0>, pg8::ListSched<decltype(f)>, true>(lds, pg8::Gemm{D, 2048, 256}, S, E);
        }
        __syncthreads();
        for (int u = bx; u < 256; u += G) { const int bn = u >> 1, gp = u & 1;
            att::gmlp_unit(Z + (size_t)bn * 128 * EVEN_N, gp, gmlp_w_s, gmlp_b_s, gmlp_v_gain, Y + (size_t)bn * 128 * D, lds); }
        __syncthreads();
        {
            gu32* ctl = (gu32*)(ws + WS_CTL);
            LAS int* qsel = (LAS int*)(lds + 140 * 1024); LAS float* thrs = (LAS float*)(qsel + 4);
            __syncthreads();
            if (tid < 8) { const int b = tid >> 2, h = tid & 3; float nq = 0.f, nk = 0.f;
#pragma unroll
                for (int w = 0; w < 4; ++w) { nq += __uint_as_float(__hip_atomic_load(ctl + CW_NRM + ((b * 2 + 0) * 4 + h) * 4 + w, RLX_AGENT)); nk += __uint_as_float(__hip_atomic_load(ctl + CW_NRM + ((b * 2 + 1) * 4 + h) * 4 + w, RLX_AGENT)); }
                thrs[tid] = (38.0f + 2.0f * 1.02f * sqrtf(nq) * sqrtf(nk)) * 0.6931471805599453f; }
            for (;;) {
                __syncthreads();
                if (threadIdx.x < 64) { int ln = threadIdx.x; asm volatile("" : "+v"(ln));
                    const int qb = (bx + ln) & 7;
                    const unsigned head = ln < 8 ? __hip_atomic_load(ctl + CW_QCTR + 64 * qb, RLX_AGENT) : 64u;
                    const unsigned long long live = __ballot(head < 64u);
                    if (ln == 0) { int r = -1;
                        if (live) { const int bhq = (bx + (int)__builtin_ctzll(live)) & 7; const int k = (int)__hip_atomic_fetch_add(ctl + CW_QCTR + 64 * bhq, 1u, RLX_AGENT); r = k < 64 ? bhq * 64 + k : -2; }
                        qsel[0] = r; } }
                __syncthreads();
                const int sel = qsel[0];
                if (sel == -1) break;
                if (sel == -2) continue;
                const int bh = sel >> 6, k = sel & 63, b = bh >> 2, h = bh & 3;
                const float* cum = CUM + (size_t)bh * SEQ; const float thr = thrs[bh];
                const int i = 63 - k, q0 = 128 * i;
                const float c0 = cum[q0];
                int ln = threadIdx.x; asm volatile("" : "+v"(ln)); ln &= 63;
                const int T1 = ln, T2 = 64 + ln;
                const bool s1 = (T1 <= 2 * i + 1) && (cum[64 * T1 + 63] - c0 >= thr), s2 = (T2 <= 2 * i + 1) && (cum[64 * T2 + 63] - c0 >= thr);
                const int tlo = __popcll(__ballot(s1)) + __popcll(__ballot(s2));
                att::fox_unit(Z + (size_t)b * SEQ * EVEN_N, h, i, __builtin_amdgcn_readfirstlane(tlo >> 1), cum, Y + (size_t)b * SEQ * D, lds);
            }
        }
        DUP_BAR(2);
    }
    SEAM_F(2);

    if (IN(3))
#pragma unroll 1
    for (int rep_ = 0; rep_ < REPS(3); ++rep_) {
        PHASE_BEGIN();
        pg8::GridSched S; S.init(M / 256, 4, G, bx, Y, (size_t)256 * D * 2, WOUT0, (size_t)256 * D * 2, 256);
        pg8::EpiResid E{nullptr, XB, SSP1};
        pg8::gemm_phase<pg8::EpiResid, pg8::GridSched, true>(lds, pg8::Gemm{D, D, D}, S, E);
        DUP_BAR(3);
    }
    SEAM_F(3);
    if (IN(4))
#pragma unroll 1
    for (int rep_ = 0; rep_ < REPS(4); ++rep_) {
        PHASE_BEGIN();
        pg8::GridSched S; S.init(M / 256, 4, G, bx, XB, (size_t)256 * D * 2, AT, (size_t)256 * D * 2, 256); S.bSel = (size_t)D * D * 2; S.pmPerSel = 32;
        pg8::EpiSoftmax E{Y, D, SSP1};
        pg8::gemm_phase<pg8::EpiSoftmax, pg8::GridSched, true>(lds, pg8::Gemm{D, D, D}, S, E);
        DUP_BAR(4);
    }
    SEAM_F(4);
    if (IN(5))
#pragma unroll 1
    for (int rep_ = 0; rep_ < REPS(5); ++rep_) {
        PHASE_BEGIN();
        pg8::GridSched S; S.init(M / 256, 4, G, bx, Y, (size_t)256 * D * 2, BT, (size_t)256 * D * 2, 256); S.bSel = (size_t)D * D * 2; S.pmPerSel = 32;
        pg8::EpiResid E{nullptr, XB, SSP2};
        pg8::gemm_phase<pg8::EpiResid, pg8::GridSched, true>(lds, pg8::Gemm{D, D, D}, S, E);
        DUP_BAR(5);
    }
    SEAM_F(5);
    if (IN(6))
#pragma unroll 1
    for (int rep_ = 0; rep_ < REPS(6); ++rep_) {
        PHASE_BEGIN();
        pg8::GridSched S; S.init(M / 256, 2 * FF / 256, G, bx, XB, (size_t)256 * D * 2, WGU0, (size_t)256 * D * 2, 128);
        pg8::EpiSwiGLU<FFN_D8 != 0> E{Z, FF, SSP2, nullptr};
        pg8::gemm_phase<pg8::EpiSwiGLU<FFN_D8 != 0>, pg8::GridSched, true>(lds, pg8::Gemm{D, D, D}, S, E);
        if (bx >= 128) MOE_CONVERT(MK_Q6);
        DUP_BAR(6);
    }
    SEAM_F(6);
    if (IN(7))
#pragma unroll 1
    for (int rep_ = 0; rep_ < REPS(7); ++rep_) {
        PHASE_BEGIN();
#if FFN_D8
        pg8::GridSched S; S.init(M / 256, 4, G, bx, Z, (size_t)256 * FF, WD0, (size_t)256 * FF, 256);
        pg8::EpiResid E{nullptr, XB, SSP3, 1.0f / 64.0f};
        pg8::gemm_phase<pg8::EpiResid, pg8::GridSched, true, true>(lds, pg8::Gemm{64, FF / 2, FF / 2, 32768}, S, E);
#else
        pg8::GridSched S; S.init(M / 256, 4, G, bx, Z, (size_t)256 * FF * 2, WD0, (size_t)256 * FF * 2, 256);
        pg8::EpiResid E{nullptr, XB, SSP3};
        pg8::gemm_phase<pg8::EpiResid, pg8::GridSched, true>(lds, pg8::Gemm{FF, FF, FF}, S, E);
#endif
        DUP_BAR(7);
    }
    SEAM_F(7);
    if (IN(8))
#pragma unroll 1
    for (int rep_ = 0; rep_ < REPS(8); ++rep_) {
        PHASE_BEGIN();
        pg8::GridSched S; S.init(M / 256, ODD_IN / 256, G, bx, XB, (size_t)256 * D * 2, WIN1, (size_t)256 * D * 2, 256);
        pg8::EpiStore<2> E{Z, ODD_IN, SSP3, 0.125f * LOG2E, (unsigned*)(ws + WS_CTL) + CW_NRM2};
        pg8::gemm_phase<pg8::EpiStore<2>, pg8::GridSched, true>(lds, pg8::Gemm{D, D, D}, S, E);
        DUP_BAR(8);
    }
    SEAM_F(8);
    if (IN(9))
#pragma unroll 1
    for (int rep_ = 0; rep_ < REPS(9); ++rep_) {
        PHASE_BEGIN();
        const float lam_init = 0.8f - 0.6f * 0.7408182206817179f;
        float lam;
        { const float s1 = wave_sum(lq1[lane] * lk1[lane]), s2 = wave_sum(lq2[lane] * lk2[lane]); lam = expf(s1) - expf(s2) + lam_init;
          lam = __builtin_bit_cast(float, __builtin_amdgcn_readfirstlane(__builtin_bit_cast(int, lam))); }
        {
            const int c0 = lane * 8;
            float cw[3][8];
#pragma unroll
            for (int w = 0; w < 3; ++w) { const f32x4 a = *(const f32x4*)(conv_w + w * 512 + c0), b2 = *(const f32x4*)(conv_w + w * 512 + c0 + 4);
                cw[w][0] = a[0]; cw[w][1] = a[1]; cw[w][2] = a[2]; cw[w][3] = a[3]; cw[w][4] = b2[0]; cw[w][5] = b2[1]; cw[w][6] = b2[2]; cw[w][7] = b2[3]; }
            for (int blk = bx; blk < M / 64; blk += G) {
#pragma unroll 1
                for (int half = 0; half < 2; ++half) {
                    const int row0 = blk * 64 + wave * 8 + half * 4; const bool head = (row0 & (SEQ - 1)) == 0;
                    u32x4 hh[6], gc[6], gb[4];
#pragma unroll
                    for (int k = 0; k < 6; ++k) { const int r = row0 - 2 + k;
                        if (k >= 2 || !head) { hh[k] = *(const u32x4*)(Z + (size_t)r * ODD_IN + 1536 + c0); gc[k] = *(const u32x4*)(Z + (size_t)r * ODD_IN + 2560 + c0); }
                        else { hh[k] = (u32x4){0u, 0u, 0u, 0u}; gc[k] = (u32x4){0u, 0u, 0u, 0u}; } }
#pragma unroll
                    for (int k = 0; k < 4; ++k) gb[k] = *(const u32x4*)(Z + (size_t)(row0 + k) * ODD_IN + 2048 + c0);
                    float z[6][8];
#pragma unroll
                    for (int k = 0; k < 6; ++k) { z[k][0] = bflo(hh[k].x) * bflo(gc[k].x); z[k][1] = bfhi(hh[k].x) * bfhi(gc[k].x); z[k][2] = bflo(hh[k].y) * bflo(gc[k].y); z[k][3] = bfhi(hh[k].y) * bfhi(gc[k].y);
                        z[k][4] = bflo(hh[k].z) * bflo(gc[k].z); z[k][5] = bfhi(hh[k].z) * bfhi(gc[k].z); z[k][6] = bflo(hh[k].w) * bflo(gc[k].w); z[k][7] = bfhi(hh[k].w) * bfhi(gc[k].w); }
#pragma unroll
                    for (int k = 0; k < 4; ++k) {
                        const float gbf[8] = {bflo(gb[k].x), bfhi(gb[k].x), bflo(gb[k].y), bfhi(gb[k].y), bflo(gb[k].z), bfhi(gb[k].z), bflo(gb[k].w), bfhi(gb[k].w)};
                        float o[8];
#pragma unroll
                        for (int c = 0; c < 8; ++c) o[c] = gbf[c] * (cw[0][c] * z[k][c] + cw[1][c] * z[k + 1][c] + cw[2][c] * z[k + 2][c]);
                        u32x4 w; w.x = cvt_pk_bf16(o[0], o[1]); w.y = cvt_pk_bf16(o[2], o[3]); w.z = cvt_pk_bf16(o[4], o[5]); w.w = cvt_pk_bf16(o[6], o[7]);
                        *(u32x4*)(Y + (size_t)(row0 + k) * D + 512 + c0) = w; }
                }
            }
        }
        __syncthreads();
        for (int v = bx; v < 256; v += G) {
            const int bh = v & 7, p = v >> 3, b = bh >> 2, h = bh & 3;
#pragma unroll 1
            for (int pass = 0; pass < 2; ++pass) {
                if (pass == 1) MOE_CONVERT(MK_Q9);
                att::diff_unit(Z + (size_t)b * SEQ * ODD_IN, h, pass ? 63 - p : p, rel_bias, subln_gain, lam, 1.0f - lam_init, Y + (size_t)b * SEQ * D, lds, (const gu32*)(ws + WS_CTL) + CW_NRM2 + b * 32);
            }
        }
        DUP_BAR(9);
    }
    SEAM_F(9);
    if (IN(10))
#pragma unroll 1
    for (int rep_ = 0; rep_ < REPS(10); ++rep_) {
        PHASE_BEGIN();
        pg8::GridSched S; S.init(M / 256, 4, G, bx, Y, (size_t)256 * D * 2, WOUT1, (size_t)256 * D * 2, 256);
        pg8::EpiResid E{nullptr, XB, SSP4};
        pg8::gemm_phase<pg8::EpiResid, pg8::GridSched, true>(lds, pg8::Gemm{D, D, D}, S, E);
        DUP_BAR(10);
    }
    SEAM_F(10);
    if (IN(11))
#pragma unroll 1
    for (int rep_ = 0; rep_ < REPS(11); ++rep_) {
        PHASE_BEGIN();
        pg8::GridSched S; S.init(M / 256, 4, G, bx, XB, (size_t)256 * D * 2, AT + (size_t)2 * D * D, (size_t)256 * D * 2, 256); S.bSel = (size_t)D * D * 2; S.pmPerSel = 32;
        pg8::EpiSoftmax E{Y, D, SSP4};
        pg8::gemm_phase<pg8::EpiSoftmax, pg8::GridSched, true>(lds, pg8::Gemm{D, D, D}, S, E);
        DUP_BAR(11);
    }
    SEAM_F(11);
    if (IN(12))
#pragma unroll 1
    for (int rep_ = 0; rep_ < REPS(12); ++rep_) {
        PHASE_BEGIN();
        pg8::GridSched S; S.init(M / 256, 4, G, bx, Y, (size_t)256 * D * 2, BT + (size_t)2 * D * D, (size_t)256 * D * 2, 256); S.bSel = (size_t)D * D * 2; S.pmPerSel = 32;
        pg8::EpiResid E{nullptr, XB, SSP0};
        pg8::gemm_phase<pg8::EpiResid, pg8::GridSched, true>(lds, pg8::Gemm{D, D, D}, S, E);
        DUP_BAR(12);
    }
    SEAM_F(12);
    if (IN(13))
#pragma unroll 1
    for (int rep_ = 0; rep_ < REPS(13); ++rep_) {
        PHASE_BEGIN();
        LAS int* sel = (LAS int*)lds;
        float wr_[8][16];
        {
            LAS float* wl = (LAS float*)(lds + 1024);
            const f32x4* src = (const f32x4*)(ws + WS_WRT);
#pragma unroll
            for (int q = 0; q < 4; ++q) *(LAS f32x4*)(wl + 4 * (tid + 512 * q)) = src[tid + 512 * q];
            __syncthreads();
#pragma unroll
            for (int x = 0; x < 8; ++x)
#pragma unroll
                for (int j = 0; j < 4; ++j) { const f32x4 v = *(const LAS f32x4*)(wl + x * D + 4 * lane + 256 * j); wr_[x][4 * j] = v[0]; wr_[x][4 * j + 1] = v[1]; wr_[x][4 * j + 2] = v[2]; wr_[x][4 * j + 3] = v[3]; }
        }
        for (int wg = bx; wg < M / 64; wg += G) {
            __syncthreads();
            u32x2 xa[4], xb[4];
            { const u32x2* xr = (const u32x2*)(XB + (size_t)(wg * 64 + wave * 8) * D) + lane;
#pragma unroll
              for (int j = 0; j < 4; ++j) xa[j] = xr[64 * j]; }
#define ROUTE_ROW(XV, rr) do { const int lr = wave * 8 + (rr), row = wg * 64 + lr; \
                float ss = 0.f, lg[8] = {0.f, 0.f, 0.f, 0.f, 0.f, 0.f, 0.f, 0.f}; \
                _Pragma("unroll") for (int j = 0; j < 4; ++j) { const f32x4 v = (f32x4){bflo(XV[j].x), bfhi(XV[j].x), bflo(XV[j].y), bfhi(XV[j].y)}; \
                    _Pragma("unroll") for (int e = 0; e < 4; ++e) { const float t = v[e]; ss += t * t; \
                        _Pragma("unroll") for (int x = 0; x < 8; ++x) lg[x] += t * wr_[x][4 * j + e]; } } \
                ss = wave_sum(ss); \
                _Pragma("unroll") for (int x = 0; x < 8; ++x) lg[x] = wave_sum(lg[x]); \
                const float r = 1.0f / sqrtf(ss * (1.0f / D) + EPS); \
                int e0 = 0; float v0 = lg[0]; \
                _Pragma("unroll") for (int x = 1; x < 8; ++x) if (lg[x] > v0) { v0 = lg[x]; e0 = x; } \
                int e1 = -1; float v1 = -3.0e38f; \
                _Pragma("unroll") for (int x = 0; x < 8; ++x) if (x != e0 && lg[x] > v1) { v1 = lg[x]; e1 = x; } \
                if (lane == 0) { const float ga = 1.0f / (1.0f + expf((v1 - v0) * r));            \
                    GATE[(size_t)row * 2] = ga; GATE[(size_t)row * 2 + 1] = 1.0f - ga; RS5[row] = r; sel[lr * 2] = e0; sel[lr * 2 + 1] = e1; } } while (0)
#pragma unroll 1
            for (int rr = 0; rr < 8; rr += 2) {
                { const u32x2* xr = (const u32x2*)(XB + (size_t)(wg * 64 + wave * 8 + rr + 1) * D) + lane;
#pragma unroll
                  for (int j = 0; j < 4; ++j) xb[j] = xr[64 * j]; }
                ROUTE_ROW(xa, rr);
                if (rr + 2 < 8) { const u32x2* xr = (const u32x2*)(XB + (size_t)(wg * 64 + wave * 8 + rr + 2) * D) + lane;
#pragma unroll
                  for (int j = 0; j < 4; ++j) xa[j] = xr[64 * j]; }
                ROUTE_ROW(xb, rr + 1);
            }
#undef ROUTE_ROW
            __syncthreads();
            if (tid < 64) { const int e0 = sel[tid * 2], e1 = sel[tid * 2 + 1]; int r0 = 0, r1 = 0;
                for (int t = 0; t < tid; ++t) { const int a = sel[t * 2], b = sel[t * 2 + 1]; r0 += (a == e0) + (b == e0); r1 += (a == e1) + (b == e1); }
                TOKE[wg * 64 + tid] = (unsigned)e0 | ((unsigned)e1 << 8) | ((unsigned)r0 << 16) | ((unsigned)r1 << 24); }
            if (tid < 8) { int c = 0; for (int t = 0; t < 64; ++t) c += (sel[t * 2] == tid) + (sel[t * 2 + 1] == tid); CNT[wg * 8 + tid] = c; }
        }
        __syncthreads();
        DUP_BAR(13);
    }
    SEAM(13);
    if (IN(14))
#pragma unroll 1
    for (int rep_ = 0; rep_ < REPS(14); ++rep_) {
        PHASE_BEGIN();
        MOE_CONVERT(1 << 20);
        LAS int* tot = (LAS int*)lds; LAS int* offs = tot + 8; LAS int* base = offs + 8;
        for (int wg = bx; wg < M / 64; wg += G) {
            __syncthreads();
            {
                LAS int* ptot = base + 8; LAS int* pbas = ptot + 512;
                const int e = tid & 7, part = tid >> 3; int t = 0, bsum = 0;
#pragma unroll
                for (int q = 0; q < 4; ++q) { const int w = part * 4 + q; const int c = CNT[w * 8 + e]; t += c; if (w < wg) bsum += c; }
                ptot[part * 8 + e] = t; pbas[part * 8 + e] = bsum;
                __syncthreads();
                if (tid < 8) { int tt = 0, bb = 0; for (int p = 0; p < 64; ++p) { tt += ptot[p * 8 + tid]; bb += pbas[p * 8 + tid]; } tot[tid] = tt; base[tid] = bb; }
                __syncthreads();
            }
            if (tid == 0) { int o = 0; for (int e = 0; e < 8; ++e) { offs[e] = o; o += ((tot[e] + 255) >> 8) << 8; } }
            __syncthreads();
            if (wg == 0) {
                for (int e = 0; e < 8; ++e) { const int a = offs[e] + tot[e], bnd = offs[e] + (((tot[e] + 255) >> 8) << 8); for (int s = a + tid; s < bnd; s += 512) RSS[s] = 0.f; }
            }
            LAS int* pslot = base + 8 + 1024;
            if (tid < 128) { const int row = wg * 64 + (tid >> 1), k = tid & 1; const unsigned te = TOKE[row];
                const int e = (te >> (8 * k)) & 0xff, lr = (te >> (16 + 8 * k)) & 0xff; const int slot = offs[e] + base[e] + lr;
                pslot[tid] = slot; SLOT[row * 2 + k] = slot; RSS[slot] = RS5[row] * (1.0f / 64.0f); }
            __syncthreads();
#pragma unroll 1
            for (int t0 = wave * 16; t0 < wave * 16 + 16; t0 += 4) {
#if MOE_FP8
                u32x4 p[4], q[4];
#pragma unroll
                for (int j = 0; j < 4; ++j) { const u32x4* src = (const u32x4*)(XB + (size_t)(wg * 64 + ((t0 + j) >> 1)) * D) + 2 * lane; p[j] = src[0]; q[j] = src[1]; }
#pragma unroll
                for (int j = 0; j < 4; ++j) { const int slot = pslot[t0 + j];
                    u32x4 o; o.x = pk4_fp8(bflo(p[j].x), bfhi(p[j].x), bflo(p[j].y), bfhi(p[j].y)); o.y = pk4_fp8(bflo(p[j].z), bfhi(p[j].z), bflo(p[j].w), bfhi(p[j].w));
                    o.z = pk4_fp8(bflo(q[j].x), bfhi(q[j].x), bflo(q[j].y), bfhi(q[j].y)); o.w = pk4_fp8(bflo(q[j].z), bfhi(q[j].z), bflo(q[j].w), bfhi(q[j].w));
                    ((u32x4*)((unsigned char*)AMOE + (size_t)slot * D))[lane] = o; }
#else
                u32x4 p[4], q[4];
#pragma unroll
                for (int j = 0; j < 4; ++j) { const u32x4* src = (const u32x4*)(XB + (size_t)(wg * 64 + ((t0 + j) >> 1)) * D); p[j] = src[lane]; q[j] = src[lane + 64]; }
#pragma unroll
                for (int j = 0; j < 4; ++j) { u32x4* dst = (u32x4*)(AMOE + (size_t)pslot[t0 + j] * D); dst[lane] = p[j]; dst[lane + 64] = q[j]; }
#endif
            }
        }
        __syncthreads();
        DUP_BAR(14);
    }
    SEAM(14);
    int tpre[9];
    if (IN(15) || IN(16)) {
        PHASE_BEGIN();
        LAS int* tot = (LAS int*)(lds + EPI_OFF + 4096);
        __syncthreads();
        {   LAS int* ptot = tot + 16;
            const int e = tid & 7, part = tid >> 3; int t = 0;
#pragma unroll
            for (int q = 0; q < 4; ++q) t += CNT[(part * 4 + q) * 8 + e];
            ptot[part * 8 + e] = t;
            __syncthreads();
            if (tid < 8) { int tt = 0; for (int p = 0; p < 64; ++p) tt += ptot[p * 8 + tid]; tot[tid] = tt; }
            __syncthreads();
        }
        tpre[0] = 0;
#pragma unroll
        for (int e = 0; e < 8; ++e) tpre[e + 1] = tpre[e] + ((tot[e] + 255) >> 8);
#pragma unroll
        for (int e = 0; e < 9; ++e) tpre[e] = __builtin_amdgcn_readfirstlane(tpre[e]);
    }
    if (IN(15))
#pragma unroll 1
    for (int rep_ = 0; rep_ < REPS(15); ++rep_) {
        PHASE_BEGIN();
        constexpr int ES = MOE_FP8 ? 1 : 2;
        pg8::GridSched S; S.init(tpre[8], 2 * FFE / 256, G, bx, AMOE, (size_t)256 * D * ES, WGUE, (size_t)256 * D * ES, 128);
        S.byTable = true; S.bSel = (size_t)2 * FFE * D * ES; S.tp1 = tpre[1]; S.tp2 = tpre[2]; S.tp3 = tpre[3]; S.tp4 = tpre[4]; S.tp5 = tpre[5]; S.tp6 = tpre[6]; S.tp7 = tpre[7];
        pg8::EpiSwiGLU<MOE_FP8> E{HMOE, FFE, nullptr, RSS};
        pg8::gemm_phase<pg8::EpiSwiGLU<MOE_FP8>, pg8::GridSched, true, MOE_FP8>(lds, pg8::Gemm{D * ES / 2, D * ES / 2, D * ES / 2}, S, E);
        DUP_BAR(15);
    }
    SEAM(15);
    if (IN(16))
#pragma unroll 1
    for (int rep_ = 0; rep_ < REPS(16); ++rep_) {
        PHASE_BEGIN();
        constexpr int ES = MOE_FP8 ? 1 : 2;
        const int nmain = tpre[8] < 128 ? tpre[8] : 128;
        pg8::GridSched S; S.init(nmain, 4, G, bx, HMOE, (size_t)256 * FFE * ES, WDE, (size_t)256 * FFE * ES, 256);
        S.byTable = true; S.bSel = (size_t)D * FFE * ES; S.tp1 = tpre[1]; S.tp2 = tpre[2]; S.tp3 = tpre[3]; S.tp4 = tpre[4]; S.tp5 = tpre[5]; S.tp6 = tpre[6]; S.tp7 = tpre[7];
        pg8::EpiStore<0> E{YMOE, D, nullptr, 1.0f, nullptr};
        pg8::gemm_phase<pg8::EpiStore<0>, pg8::GridSched, true, MOE_FP8>(lds, pg8::Gemm{64, FFE * ES / 2, FFE * ES / 2, 32768}, S, E);
        {
            const int t1 = tpre[1], t2 = tpre[2], t3 = tpre[3], t4 = tpre[4], t5 = tpre[5], t6 = tpre[6], t7 = tpre[7];
            const unsigned char* hm = (const unsigned char*)HMOE; const unsigned char* wd = (const unsigned char*)WDE;
            auto f = [=](int L, pg8::Unit& u) { const int pmt = L / 28, r = L % 28, pn = r / 7, kc = r % 7, pm = 128 + pmt;
                const int e = (pm >= t1) + (pm >= t2) + (pm >= t3) + (pm >= t4) + (pm >= t5) + (pm >= t6) + (pm >= t7);
                u.a = (const char*)(hm + (size_t)pm * 256 * FFE + (size_t)kc * 4 * 32768); u.b = (const char*)(wd + (size_t)e * D * FFE + (size_t)pn * 256 * FFE + kc * 512);
                u.orow = 0; u.ocol = 0; u.tag = (pmt * 4 + pn) * 7 + kc; u.pad = 0; };
            pg8::ListSched<decltype(f)> S2{(tpre[8] - nmain) * 28, G, bx, f};
            pg8::EpiPart E2{(float*)(ws + WS_PART)};
            pg8::gemm_phase<pg8::EpiPart, pg8::ListSched<decltype(f)>, true, true>(lds, pg8::Gemm{64, FFE / 2, 256, 32768}, S2, E2);
        }
        DUP_BAR(16);
    }
    SEAM(16);
    if (IN(17))
#pragma unroll 1
    for (int rep_ = 0; rep_ < REPS(17); ++rep_) {
        PHASE_BEGIN();
        for (int row = gw; row < M; row += NGW) {
            const int s0 = SLOT[row * 2], s1 = SLOT[row * 2 + 1]; const float g0 = GATE[(size_t)row * 2] * (MOE_FP8 ? 1.0f / 64.0f : 1.0f), g1 = GATE[(size_t)row * 2 + 1] * (MOE_FP8 ? 1.0f / 64.0f : 1.0f);
            f32x4* xr = (f32x4*)(XF + (size_t)row * D) + lane; const u32x2* xq = (const u32x2*)(XB + (size_t)row * D) + lane;
            const u32x2* y0 = (const u32x2*)(YMOE + (size_t)s0 * D) + lane; const u32x2* y1 = (const u32x2*)(YMOE + (size_t)s1 * D) + lane;
            const f32x4* gr = (const f32x4*)norm_final + lane; const float* part = (const float*)(ws + WS_PART);
            f32x4 v[4]; float ss = 0.f;
            u32x2 xw[4], ra[4], rb[4];
#pragma unroll
            for (int j = 0; j < 4; ++j) { xw[j] = xq[64 * j]; ra[j] = y0[64 * j]; rb[j] = y1[64 * j]; }
#pragma unroll
            for (int j = 0; j < 4; ++j) { const f32x4 xv = (f32x4){bflo(xw[j].x), bfhi(xw[j].x), bflo(xw[j].y), bfhi(xw[j].y)};
                f32x4 ya = (f32x4){bflo(ra[j].x), bfhi(ra[j].x), bflo(ra[j].y), bfhi(ra[j].y)}, yb = (f32x4){bflo(rb[j].x), bfhi(rb[j].x), bflo(rb[j].y), bfhi(rb[j].y)};
                if (s0 >= 32768) {
                    const float* pp = part + ((size_t)(((s0 >> 8) - 128) * 4 + j) * 7) * 65536 + (size_t)(s0 & 255) * 256 + 4 * lane; ya = *(const f32x4*)pp;
#pragma unroll
                    for (int kc = 1; kc < 7; ++kc) ya = ya + *(const f32x4*)(pp + (size_t)kc * 65536); }
                if (s1 >= 32768) {
                    const float* pp = part + ((size_t)(((s1 >> 8) - 128) * 4 + j) * 7) * 65536 + (size_t)(s1 & 255) * 256 + 4 * lane; yb = *(const f32x4*)pp;
#pragma unroll
                    for (int kc = 1; kc < 7; ++kc) yb = yb + *(const f32x4*)(pp + (size_t)kc * 65536); }
                v[j][0] = xv[0] + g0 * ya[0] + g1 * yb[0]; v[j][1] = xv[1] + g0 * ya[1] + g1 * yb[1]; v[j][2] = xv[2] + g0 * ya[2] + g1 * yb[2]; v[j][3] = xv[3] + g0 * ya[3] + g1 * yb[3];
                ss += (v[j][0] * v[j][0] + v[j][1] * v[j][1]) + (v[j][2] * v[j][2] + v[j][3] * v[j][3]); }
            ss = wave_sum(ss); const float r = 1.0f / sqrtf(ss * (1.0f / D) + EPS);
#pragma unroll
            for (int j = 0; j < 4; ++j) { const f32x4 g = gr[64 * j]; xr[64 * j] = (f32x4){v[j][0] * r * g[0], v[j][1] * r * g[1], v[j][2] * r * g[2], v[j][3] * r * g[3]}; }
        }
    }
#undef IN
#undef SEAM
#undef SEAM_F
}

extern "C" void kernel_launch(void* const* d_in, const int* in_sizes, int n_in, void* d_out, int out_size, void* d_ws, size_t ws_size, hipStream_t stream) {
    static int grid = 0;
    if (grid == 0) {
        if (n_in != 32 || in_sizes[0] != M * D || out_size != M * D || ws_size < WS_END) {
            fprintf(stderr, "kernel_launch: unexpected shapes (n_in %d, in0 %d, out %d, ws %zu, need %zu); nothing launched\n", n_in, n_in > 0 ? in_sizes[0] : -1, out_size, ws_size, (size_t)WS_END); grid = -1; return; }
        int dev = 0, cus = 0;
        if (hipGetDevice(&dev) != hipSuccess || hipDeviceGetAttribute(&cus, hipDeviceAttributeMultiprocessorCount, dev) != hipSuccess) { grid = -1; return; }
        if (hipFuncSetAttribute((const void*)mk_fwd, hipFuncAttributeMaxDynamicSharedMemorySize, LDS_BYTES) != hipSuccess) { fprintf(stderr, "kernel_launch: hipFuncSetAttribute failed\n"); grid = -1; return; }
        int per_cu = 0;
        if (hipOccupancyMaxActiveBlocksPerMultiprocessor(&per_cu, (const void*)mk_fwd, 512, LDS_BYTES) != hipSuccess || per_cu < 1) fprintf(stderr, "kernel_launch: occupancy query says %d\n", per_cu);
        (void)hipGetLastError();
        grid = cus;
    }
    if (grid < 0) return;
    (void)hipMemsetAsync((char*)d_ws + WS_CTL, 0, CTL_ZERO_BYTES, stream);
    Args a{};
    for (int i = 0; i < 32; ++i) a.in[i] = (const float*)d_in[i];
    a.out = (float*)d_out; a.ws = (unsigned char*)d_ws;
#if MK_PER_PHASE
    for (int p = 0; p < NPHASE; ++p) { a.ph_lo = p; a.ph_hi = p + 1; hipLaunchKernelGGL(mk_fwd, dim3(grid), dim3(512), LDS_BYTES, stream, a); }
#else
    a.ph_lo = 0; a.ph_hi = NPHASE; hipLaunchKernelGGL(mk_fwd, dim3(grid), dim3(512), LDS_BYTES, stream, a);
#endif
    const hipError_t le = hipPeekAtLastError();
    if (le != hipSuccess) fprintf(stderr, "kernel_launch: launch failed: %s\n", hipGetErrorName(le));
}
```
